# Optimizing an MI355X kernel written in HIP

```python
import jax, jax.numpy as jnp
from jax import lax
import numpy as np

D_MODEL = 1024
BATCH = 8
SEQ = 4096
DEPTH = 1
DEC_BATCH = 16
DEC_SEQ = 64
PAST_LEN = 4096

CHUNK = 64
N_PREV_CHUNKS = 8
BAND_PAST = N_PREV_CHUNKS * CHUNK
BAND = BAND_PAST + CHUNK
HEAD_DIM = 64
H_A = 8
H_B = 8
WIDTH_A = H_A * HEAD_DIM
WIDTH_B = H_B * HEAD_DIM
MIX_WIDTH = WIDTH_A + WIDTH_B
IN_COLS = 3 * WIDTH_A + 3 * WIDTH_B + H_B
REL_CLIP = 128
Q_BLOCK = 128
N_MEM = 256
H_M = 4
HEAD_DIM_M = D_MODEL // H_M
D_FF = 2816
CONV_W = 3
EPS = 1e-6

kernel_name = "hybrid_chunk_band_fox_stream_step"


def rms_norm(x, g):
    x32 = x.astype(jnp.float32)
    y = x32 * lax.rsqrt(jnp.mean(x32 * x32, axis=-1, keepdims=True) + EPS)
    return (y * g.astype(jnp.float32)).astype(x.dtype)


def attend(q, k, v, bias, mask):
    scale = q.shape[-1] ** -0.5
    logits = jnp.einsum('bqhd,bkhd->bhqk', q, k).astype(jnp.float32) * scale
    if bias is not None:
        logits = logits + bias
    if mask is not None:
        logits = jnp.where(mask, logits, -jnp.inf)
    p = jax.nn.softmax(logits, axis=-1)
    return jnp.einsum('bhqk,bkhd->bqhd', p.astype(v.dtype), v)


def in_proj(h, w_in, b_f, g_qa, g_ka, g_qb, g_kb):
    b, t, _ = h.shape
    p = h @ w_in
    def heads(lo, width, nh):
        return p[..., lo:lo + width].reshape(b, t, nh, HEAD_DIM)
    qa = rms_norm(heads(0, WIDTH_A, H_A), g_qa)
    ka = rms_norm(heads(WIDTH_A, WIDTH_A, H_A), g_ka)
    va = heads(2 * WIDTH_A, WIDTH_A, H_A)
    o = 3 * WIDTH_A
    qb = rms_norm(heads(o, WIDTH_B, H_B), g_qb)
    kb = rms_norm(heads(o + WIDTH_B, WIDTH_B, H_B), g_kb)
    vb = heads(o + 2 * WIDTH_B, WIDTH_B, H_B)
    f_logit = p[..., o + 3 * WIDTH_B:]
    logf = jax.nn.log_sigmoid(f_logit.astype(jnp.float32) + b_f.astype(jnp.float32))
    return qa, ka, va, qb, kb, vb, logf


def rel_bias_lookup(table, tq, ts):
    rel = jnp.clip(tq[:, None] - ts[None, :], -REL_CLIP, REL_CLIP) + REL_CLIP
    return table.astype(jnp.float32)[:, rel][None]


def chunk_band_attn_prompt(qa, ka, va, table):
    b, t, h, d = qa.shape
    pad = jnp.zeros((b, BAND_PAST, h, d), ka.dtype)
    kp = jnp.concatenate([pad, ka], axis=1)
    vp = jnp.concatenate([pad.astype(va.dtype), va], axis=1)
    def one_chunk(c):
        start = c * CHUNK
        q_c = lax.dynamic_slice_in_dim(qa, start, CHUNK, 1)
        k_c = lax.dynamic_slice_in_dim(kp, start, BAND, 1)
        v_c = lax.dynamic_slice_in_dim(vp, start, BAND, 1)
        tq = start + jnp.arange(CHUNK)
        ts = start - BAND_PAST + jnp.arange(BAND)
        bias = rel_bias_lookup(table, tq, ts)
        mask = (ts >= 0)[None, None, None, :]
        return attend(q_c, k_c, v_c, bias, mask)
    out = lax.map(one_chunk, jnp.arange(t // CHUNK))
    return jnp.moveaxis(out, 0, 1).reshape(b, t, h * d)


def chunk_band_attn_sample(qa, ka, va, cache_k, cache_v, table):
    b, s, h, d = qa.shape
    la = cache_k.shape[1]
    k = jnp.concatenate([cache_k, ka], axis=1)
    v = jnp.concatenate([cache_v, va], axis=1)
    tq = la + jnp.arange(s)
    ts = jnp.arange(la + s)
    bias = rel_bias_lookup(table, tq, ts)
    return attend(qa, k, v, bias, None).reshape(b, s, h * d)


def forget_attn_prompt(qb, kb, vb, logf):
    b, t, h, d = qb.shape
    cum_h = jnp.cumsum(logf, axis=1).transpose(0, 2, 1)
    ts = jnp.arange(t)
    def one_block(i):
        start = i * Q_BLOCK
        q_i = lax.dynamic_slice_in_dim(qb, start, Q_BLOCK, 1)
        c_i = lax.dynamic_slice_in_dim(cum_h, start, Q_BLOCK, 2)
        bias = c_i[..., :, None] - cum_h[..., None, :]
        tq = start + jnp.arange(Q_BLOCK)
        mask = (tq[:, None] >= ts[None, :])[None, None]
        return attend(q_i, kb, vb, bias, mask)
    out = lax.map(one_block, jnp.arange(t // Q_BLOCK))
    return jnp.moveaxis(out, 0, 1).reshape(b, t, h * d)


def forget_attn_sample(qb, kb, vb, logf, cache_k, cache_v, cache_logf):
    b, s, h, d = qb.shape
    p = cache_k.shape[1]
    k = jnp.concatenate([cache_k, kb], axis=1)
    v = jnp.concatenate([cache_v, vb], axis=1)
    all_logf = jnp.concatenate([cache_logf.astype(jnp.float32), logf], axis=1)
    cum_h = jnp.cumsum(all_logf, axis=1).transpose(0, 2, 1)
    bias = cum_h[..., p:, None] - cum_h[..., None, :]
    tq = p + jnp.arange(s)
    ts = jnp.arange(p + s)
    mask = (tq[:, None] >= ts[None, :])[None, None]
    return attend(qb, k, v, bias, mask).reshape(b, s, h * d)


def mem_kv(mem, g_mem, w_mkv, g_mk):
    b, n, _ = mem.shape
    kv = rms_norm(mem, g_mem) @ w_mkv
    k = rms_norm(kv[..., :D_MODEL].reshape(b, n, H_M, HEAD_DIM_M), g_mk)
    v = kv[..., D_MODEL:].reshape(b, n, H_M, HEAD_DIM_M)
    return k, v


def mem_attend(h, mk, mv, w_mq, g_mq, w_mo):
    b, t, _ = h.shape
    q = rms_norm((h @ w_mq).reshape(b, t, H_M, HEAD_DIM_M), g_mq)
    return attend(q, mk, mv, None, None).reshape(b, t, D_MODEL) @ w_mo


def conv_ffn(h, prev, w_up, w_conv, b_conv, w_down):
    gu = h @ w_up
    gate, val = gu[..., :D_FF], gu[..., D_FF:]
    t = gate.shape[1]
    gp = jnp.concatenate([prev.astype(gate.dtype), gate], axis=1)
    conv = sum(gp[:, j:j + t] * w_conv[j] for j in range(CONV_W)) + b_conv
    y = (jax.nn.silu(conv) * val) @ w_down
    return y, gp[:, -(CONV_W - 1):]


def setup_inputs(seed: int = 0) -> dict:
    key = jax.random.key(seed)
    ks = jax.random.split(key, 32)
    f32 = jnp.float32
    L = DEPTH
    la = min(BAND_PAST, PAST_LEN)
    def nrm(k, shape, scale=1.0):
        return jax.random.normal(k, shape, f32) * scale
    def gain(k, shape):
        return 1.0 + 0.1 * nrm(k, shape)
    return {
        'x_prompt': nrm(ks[0], (BATCH, SEQ, D_MODEL)),
        'x_sample': nrm(ks[1], (DEC_BATCH, DEC_SEQ, D_MODEL)),
        'cache_a_k': nrm(ks[2], (L, DEC_BATCH, la, H_A, HEAD_DIM)),
        'cache_a_v': nrm(ks[3], (L, DEC_BATCH, la, H_A, HEAD_DIM)),
        'cache_b_k': nrm(ks[4], (L, DEC_BATCH, PAST_LEN, H_B, HEAD_DIM)),
        'cache_b_v': nrm(ks[5], (L, DEC_BATCH, PAST_LEN, H_B, HEAD_DIM)),
        'cache_b_logf': jax.nn.log_sigmoid(3.0 + nrm(ks[6], (L, DEC_BATCH, PAST_LEN, H_B))),
        'cache_mem_k': nrm(ks[7], (L, DEC_BATCH, N_MEM, H_M, HEAD_DIM_M)),
        'cache_mem_v': nrm(ks[8], (L, DEC_BATCH, N_MEM, H_M, HEAD_DIM_M)),
        'state_conv': nrm(ks[9], (L, DEC_BATCH, CONV_W - 1, D_FF)),
        'mem_prompt': nrm(ks[10], (BATCH, N_MEM, D_MODEL)),
        'w_in': nrm(ks[11], (L, D_MODEL, IN_COLS), D_MODEL ** -0.5),
        'b_f': 3.0 + 0.1 * nrm(ks[12], (L, H_B)),
        'g_qa': gain(ks[13], (L, HEAD_DIM)),
        'g_ka': gain(ks[14], (L, HEAD_DIM)),
        'rel_bias': nrm(ks[15], (L, H_A, 2 * REL_CLIP + 1), 0.1),
        'g_qb': gain(ks[16], (L, HEAD_DIM)),
        'g_kb': gain(ks[17], (L, HEAD_DIM)),
        'w_o': nrm(ks[18], (L, MIX_WIDTH, D_MODEL), MIX_WIDTH ** -0.5),
        'g_norm1': gain(ks[19], (L, D_MODEL)),
        'g_norm2': gain(ks[20], (L, D_MODEL)),
        'g_mem': gain(ks[21], (L, D_MODEL)),
        'w_mq': nrm(ks[22], (L, D_MODEL, D_MODEL), D_MODEL ** -0.5),
        'w_mkv': nrm(ks[23], (L, D_MODEL, 2 * D_MODEL), D_MODEL ** -0.5),
        'g_mq': gain(ks[24], (L, HEAD_DIM_M)),
        'g_mk': gain(ks[25], (L, HEAD_DIM_M)),
        'w_mo': nrm(ks[26], (L, D_MODEL, D_MODEL), D_MODEL ** -0.5),
        'g_norm3': gain(ks[27], (L, D_MODEL)),
        'w_up': nrm(ks[28], (L, D_MODEL, 2 * D_FF), D_MODEL ** -0.5),
        'w_conv': nrm(ks[29], (L, CONV_W, D_FF), CONV_W ** -0.5),
        'b_conv': nrm(ks[30], (L, D_FF), 0.02),
        'w_down': nrm(ks[31], (L, D_FF, D_MODEL), D_FF ** -0.5),
    }


def reference(x_prompt, x_sample, cache_a_k, cache_a_v, cache_b_k, cache_b_v, cache_b_logf,
              cache_mem_k, cache_mem_v, state_conv, mem_prompt,
              w_in, b_f, g_qa, g_ka, rel_bias, g_qb, g_kb, w_o, g_norm1, g_norm2, g_mem,
              w_mq, w_mkv, g_mq, g_mk, w_mo, g_norm3, w_up, w_conv, b_conv, w_down):
    xp, xs = x_prompt, x_sample
    bp, tp = xp.shape[0], xp.shape[1]
    la_p = min(BAND_PAST, tp)
    ak_p, av_p, bk_p, bv_p, bl_p, mk_p, mv_p, cv_p = [], [], [], [], [], [], [], []
    ak_s, av_s, bk_s, bv_s, bl_s, cv_s = [], [], [], [], [], []
    for l in range(DEPTH):
        h = rms_norm(xp, g_norm1[l])
        qa, ka, va, qb, kb, vb, logf = in_proj(h, w_in[l], b_f[l], g_qa[l], g_ka[l], g_qb[l], g_kb[l])
        oa = chunk_band_attn_prompt(qa, ka, va, rel_bias[l])
        ob = forget_attn_prompt(qb, kb, vb, logf)
        xp = xp + jnp.concatenate([oa, ob], axis=-1) @ w_o[l]
        mk, mv = mem_kv(mem_prompt, g_mem[l], w_mkv[l], g_mk[l])
        xp = xp + mem_attend(rms_norm(xp, g_norm2[l]), mk, mv, w_mq[l], g_mq[l], w_mo[l])
        zeros_prev = jnp.zeros((bp, CONV_W - 1, D_FF), xp.dtype)
        f, conv_p = conv_ffn(rms_norm(xp, g_norm3[l]), zeros_prev, w_up[l], w_conv[l], b_conv[l], w_down[l])
        xp = xp + f
        ak_p.append(ka[:, tp - la_p:]); av_p.append(va[:, tp - la_p:])
        bk_p.append(kb); bv_p.append(vb); bl_p.append(logf)
        mk_p.append(mk); mv_p.append(mv); cv_p.append(conv_p)

        h = rms_norm(xs, g_norm1[l])
        qa, ka, va, qb, kb, vb, logf = in_proj(h, w_in[l], b_f[l], g_qa[l], g_ka[l], g_qb[l], g_kb[l])
        oa = chunk_band_attn_sample(qa, ka, va, cache_a_k[l], cache_a_v[l], rel_bias[l])
        ob = forget_attn_sample(qb, kb, vb, logf, cache_b_k[l], cache_b_v[l], cache_b_logf[l])
        xs = xs + jnp.concatenate([oa, ob], axis=-1) @ w_o[l]
        xs = xs + mem_attend(rms_norm(xs, g_norm2[l]), cache_mem_k[l], cache_mem_v[l], w_mq[l], g_mq[l], w_mo[l])
        f, conv_s = conv_ffn(rms_norm(xs, g_norm3[l]), state_conv[l], w_up[l], w_conv[l], b_conv[l], w_down[l])
        xs = xs + f
        ak_s.append(ka); av_s.append(va)
        bk_s.append(kb); bv_s.append(vb); bl_s.append(logf)
        cv_s.append(conv_s)

    st = lambda lst: jnp.stack(lst, axis=0)
    return (xp, xs,
            st(ak_p), st(av_p), st(bk_p), st(bv_p), st(bl_p), st(mk_p), st(mv_p), st(cv_p),
            st(ak_s), st(av_s), st(bk_s), st(bv_s), st(bl_s), st(cv_s))
```

```cpp
#include <hip/hip_runtime.h>
#include <hip/hip_cooperative_groups.h>
#include <cstdio>
#include <cstdint>
namespace cg = cooperative_groups;
namespace pg8 {
#define PG8_LAS __attribute__((address_space(3)))
typedef unsigned short bf16_t;
typedef short bf16x8 __attribute__((ext_vector_type(8)));
typedef float f32x4 __attribute__((ext_vector_type(4)));
typedef unsigned u32x4 __attribute__((ext_vector_type(4)));
constexpr int BM = 256, BK = 64, HALF = 128, HTB = HALF * BK * 2  , STAGE_BYTES = 8 * HTB, NXCD = 8, WGM = 8;

__host__ __device__ __forceinline__ int lds_byte(int r, int c) { const int st = (r >> 4) * 2 + (c >> 5), rr = r & 15, cc = c & 31, ob = rr * 64 + cc * 2; return st * 1024 + (ob ^ (((ob >> 9) & 1) << 5)); }
__host__ __device__ __forceinline__ void stage_rc(int b, int& R, int& C) { const int st = b / 1024, sb = b % 1024, swz = sb ^ (((sb >> 9) & 1) << 5); R = (st >> 1) * 16 + swz / 64; C = (st & 1) * 32 + (swz % 64) / 2; }
__host__ __device__ __forceinline__ int perm32(int rho) { const int n = rho >> 4, i = rho & 15; return 8 * (i >> 2) + 4 * n + (i & 3); }

struct Unit { int pm, pn; };
struct Gemm { const bf16_t* A; const bf16_t* Bt; int M, N, K; };

struct StaticOrder {
    int nM, nN, nwg, G, c;
    __host__ __device__ void init(int M, int N, int G_, int c_) { nM = M / BM; nN = N / BM; nwg = nM * nN; G = G_; c = c_; }
    __host__ __device__ bool next(int i, Unit& u) const {
        const long L = (long)i * G + c; if (L >= nwg) return false;
        int wgid = (int)L; { const int q = nwg / NXCD, r = nwg % NXCD, xcd = wgid % NXCD, off = wgid / NXCD; wgid = (xcd < r ? xcd * (q + 1) : r * (q + 1) + (xcd - r) * q) + off; }
        const int nig = WGM * nN, gid = wgid / nig, fm = gid * WGM, gsz = (nM - fm) < WGM ? (nM - fm) : WGM;
        u.pm = fm + ((wgid % nig) % gsz); u.pn = (wgid % nig) / gsz; return true;
    }
    __device__ __forceinline__ void a_ready(const Unit&) const {}
    __device__ __forceinline__ void done(const Unit&) const {}
};

typedef float f32x2 __attribute__((ext_vector_type(2)));
__device__ __forceinline__ unsigned cvt_pk_bf16(float lo, float hi) { unsigned r; asm volatile("v_cvt_pk_bf16_f32 %0, %1, %2" : "=v"(r) : "v"(lo), "v"(hi)); return r; }
template <class Epi, class Sched, bool ALIGN_EPI = false, bool SP2 = false>
__device__ __forceinline__ void gemm_phase(PG8_LAS unsigned char* lds, const Gemm g, const Sched& S, const Epi& E) {
    int tid_ = threadIdx.x; asm volatile("" : "+v"(tid_));
    const int tid = tid_, wid = __builtin_amdgcn_readfirstlane(tid >> 6), lane = tid & 63, wr = wid >> 2, wc = wid & 3, fr = lane & 15, fq = lane >> 4;
    const int K = g.K, nt = K / BK;
    unsigned voffA[2], voffB[2];
#pragma unroll
    for (int i = 0; i < 2; ++i) { int R, C; stage_rc(tid * 16 + i * 8192, R, C); const int Rb = Epi::PERM ? ((R & ~31) + perm32(R & 31)) : R;
        voffA[i] = (unsigned)(R * K + C) * 2u; voffB[i] = (unsigned)(Rb * K + C) * 2u; }
    const size_t kstep = (size_t)(BK * 2);
    const size_t hstep = (size_t)HALF * K * 2;
    const size_t tstep = 2 * hstep;
    const unsigned ldsw = (unsigned)wid * 1024u;
    const int aoff = lds_byte(wr * 64 + fr, fq * 8), boff = lds_byte(wc * 32 + fr, fq * 8);
#define PG8_SA(b, h) (((b) * 2 + (h)) * HTB)
#define PG8_SB(b, h) ((4 + (b) * 2 + (h)) * HTB)
#define PG8_STAGE(bufoff, gbase, voff) do { _Pragma("unroll") for (int _i = 0; _i < 2; ++_i) \
        __builtin_amdgcn_global_load_lds((const unsigned*)((const char*)(gbase) + (voff)[_i]), (PG8_LAS unsigned*)(lds + (bufoff) + ldsw + _i * 8192), 16, 0, 0); } while (0)
#define PG8_LDA(dst, b, h) do { _Pragma("unroll") for (int m = 0; m < 4; ++m) _Pragma("unroll") for (int k = 0; k < 2; ++k) dst[m][k] = *(const PG8_LAS bf16x8*)(lds + PG8_SA(b, h) + aoff + m * 2048 + k * 1024); } while (0)
#define PG8_LDB(dst, b, h) do { _Pragma("unroll") for (int n = 0; n < 2; ++n) _Pragma("unroll") for (int k = 0; k < 2; ++k) dst[n][k] = *(const PG8_LAS bf16x8*)(lds + PG8_SB(b, h) + boff + n * 2048 + k * 1024); } while (0)
#define PG8_MMA(ai, bj, At, Bt) do { __builtin_amdgcn_s_setprio(1); _Pragma("unroll") for (int m = 0; m < 4; ++m) _Pragma("unroll") for (int n = 0; n < 2; ++n) _Pragma("unroll") for (int k = 0; k < 2; ++k) \
        acc[ai][bj][m][n] = __builtin_amdgcn_mfma_f32_16x16x32_bf16(Bt[n][k], At[m][k], acc[ai][bj][m][n], 0, 0, 0); __builtin_amdgcn_s_setprio(0); } while (0)
#define PG8_WAIT_V(n) asm volatile("s_waitcnt vmcnt(" #n ")" ::: "memory")
#define PG8_WAIT_L(n) asm volatile("s_waitcnt lgkmcnt(" #n ")" ::: "memory")
#define PG8_BAR __builtin_amdgcn_s_barrier()
#define PG8_SCHED __builtin_amdgcn_sched_barrier(0)
    Unit cur, nxt; int ui = 0;
    if (!S.next(0, cur)) return;
    f32x4 acc[2][2][4][2];
#pragma unroll
    for (int a = 0; a < 2; ++a)
#pragma unroll
        for (int b = 0; b < 2; ++b)
#pragma unroll
            for (int m = 0; m < 4; ++m)
#pragma unroll
                for (int n = 0; n < 2; ++n) acc[a][b][m][n] = (f32x4){0.f, 0.f, 0.f, 0.f};
    bf16x8 At[4][2], B0[2][2], B1[2][2];
    const char* cA = (const char*)g.A + (size_t)cur.pm * tstep; const char* cB = (const char*)g.Bt + (size_t)cur.pn * tstep;
    S.a_ready(cur);
    if constexpr (SP2) {
        PG8_STAGE(PG8_SB(0, 0), cB, voffB); PG8_STAGE(PG8_SB(0, 1), cB + hstep, voffB); PG8_STAGE(PG8_SA(0, 0), cA, voffA); PG8_STAGE(PG8_SA(0, 1), cA + hstep, voffA);
        if (wr == 1) PG8_BAR;
        PG8_WAIT_V(2); PG8_BAR;
        PG8_STAGE(PG8_SB(1, 0), cB + kstep, voffB); PG8_STAGE(PG8_SA(1, 0), cA + kstep, voffA); PG8_STAGE(PG8_SB(1, 1), cB + hstep + kstep, voffB);
        PG8_WAIT_V(6); PG8_BAR;
    } else {
        PG8_STAGE(PG8_SB(0, 0), cB, voffB); PG8_STAGE(PG8_SA(0, 0), cA, voffA); PG8_STAGE(PG8_SB(0, 1), cB + hstep, voffB); PG8_STAGE(PG8_SA(0, 1), cA + hstep, voffA);
        if (wr == 1) PG8_BAR;
        PG8_WAIT_V(4); PG8_BAR;
        PG8_STAGE(PG8_SB(1, 0), cB + kstep, voffB); PG8_STAGE(PG8_SA(1, 0), cA + kstep, voffA); PG8_STAGE(PG8_SB(1, 1), cB + hstep + kstep, voffB);
        PG8_WAIT_V(6); PG8_BAR;
    }
    for (;;) {
        const bool has_next = S.next(ui + 1, nxt);
        const char* nA = has_next ? (const char*)g.A + (size_t)nxt.pm * tstep : cA; const char* nB = has_next ? (const char*)g.Bt + (size_t)nxt.pn * tstep : cB;
        for (int t = 0; t < nt; t += 2) {
            const bool last = (t == nt - 2);
            const char* a1 = cA + (size_t)(t + 1) * kstep;
            const char* a2 = last ? nA : cA + (size_t)(t + 2) * kstep; const char* b2 = last ? nB : cB + (size_t)(t + 2) * kstep;
            const char* a3 = a2 + kstep; const char* b3 = b2 + kstep;
            if (last && has_next) S.a_ready(nxt);
            if constexpr (SP2) {
            PG8_LDB(B0, 0, 0); PG8_LDB(B1, 0, 1); PG8_SCHED; PG8_LDA(At, 0, 0); PG8_STAGE(PG8_SA(1, 1), a1 + hstep, voffA);
            PG8_WAIT_V(8); PG8_WAIT_L(0); PG8_BAR; PG8_MMA(0, 0, At, B0); PG8_MMA(0, 1, At, B1); PG8_BAR; PG8_SCHED;
            PG8_LDA(At, 0, 1); PG8_STAGE(PG8_SB(0, 0), b2, voffB); PG8_STAGE(PG8_SB(0, 1), b2 + hstep, voffB); PG8_STAGE(PG8_SA(0, 0), a2, voffA);
            PG8_WAIT_V(8); PG8_WAIT_L(0); PG8_BAR; PG8_MMA(1, 0, At, B0); PG8_MMA(1, 1, At, B1); PG8_BAR; PG8_SCHED;
            PG8_LDB(B0, 1, 0); PG8_LDB(B1, 1, 1); PG8_SCHED; PG8_LDA(At, 1, 0); PG8_STAGE(PG8_SA(0, 1), a2 + hstep, voffA);
            PG8_WAIT_V(8); PG8_WAIT_L(0); PG8_BAR; PG8_MMA(0, 0, At, B0); PG8_MMA(0, 1, At, B1); PG8_BAR; PG8_SCHED;
            PG8_LDA(At, 1, 1); PG8_STAGE(PG8_SB(1, 0), b3, voffB); PG8_STAGE(PG8_SB(1, 1), b3 + hstep, voffB); PG8_STAGE(PG8_SA(1, 0), a3, voffA);
            PG8_WAIT_V(8); PG8_WAIT_L(0); PG8_BAR; PG8_MMA(1, 0, At, B0); PG8_MMA(1, 1, At, B1); PG8_BAR; PG8_SCHED;
            } else {
            PG8_LDB(B0, 0, 0); PG8_SCHED; PG8_LDA(At, 0, 0); PG8_STAGE(PG8_SA(1, 1), a1 + hstep, voffA);
            PG8_WAIT_L(8); PG8_BAR; PG8_WAIT_L(0); PG8_MMA(0, 0, At, B0); PG8_BAR; PG8_SCHED;
            PG8_LDB(B1, 0, 1); PG8_STAGE(PG8_SB(0, 0), b2, voffB);
            PG8_BAR; PG8_WAIT_L(0); PG8_MMA(0, 1, At, B1); PG8_BAR;
            PG8_LDA(At, 0, 1); PG8_STAGE(PG8_SA(0, 0), a2, voffA);
            PG8_BAR; PG8_WAIT_L(0); PG8_MMA(1, 0, At, B0); PG8_BAR; PG8_SCHED;
            PG8_STAGE(PG8_SB(0, 1), b2 + hstep, voffB);
            PG8_WAIT_V(6); PG8_BAR; PG8_MMA(1, 1, At, B1); PG8_BAR;
            PG8_LDB(B0, 1, 0); PG8_SCHED; PG8_LDA(At, 1, 0); PG8_STAGE(PG8_SA(0, 1), a2 + hstep, voffA);
            PG8_WAIT_L(8); PG8_BAR; PG8_WAIT_L(0); PG8_MMA(0, 0, At, B0); PG8_BAR; PG8_SCHED;
            PG8_LDB(B1, 1, 1); PG8_STAGE(PG8_SB(1, 0), b3, voffB);
            PG8_BAR; PG8_WAIT_L(0); PG8_MMA(0, 1, At, B1); PG8_BAR;
            PG8_LDA(At, 1, 1); PG8_STAGE(PG8_SA(1, 0), a3, voffA);
            PG8_BAR; PG8_WAIT_L(0); PG8_MMA(1, 0, At, B0); PG8_BAR; PG8_SCHED;
            PG8_STAGE(PG8_SB(1, 1), b3 + hstep, voffB);
            PG8_WAIT_V(6); PG8_BAR; PG8_MMA(1, 1, At, B1); PG8_BAR;
            }
        }
        if constexpr (ALIGN_EPI) { if (wr == 0) PG8_BAR; }
        if constexpr (!Epi::AFTER_DRAIN) { E(acc, cur, wr, wc, fr, fq); S.done(cur); }
        if (!has_next) break;
#pragma unroll
        for (int a = 0; a < 2; ++a)
#pragma unroll
            for (int b = 0; b < 2; ++b)
#pragma unroll
                for (int m = 0; m < 4; ++m)
#pragma unroll
                    for (int n = 0; n < 2; ++n) acc[a][b][m][n] = (f32x4){0.f, 0.f, 0.f, 0.f};
        cur = nxt; cA = nA; cB = nB; ++ui;
        if constexpr (ALIGN_EPI) { if (wr == 1) PG8_BAR; }
    }
    PG8_WAIT_V(0);
    if constexpr (!ALIGN_EPI) { if (wr == 0) PG8_BAR; }
    PG8_BAR;
    if constexpr (Epi::AFTER_DRAIN) { E.fused(acc, cur, wr, wc, fr, fq, lds, wid, lane); S.done(cur); }
#undef PG8_SA
#undef PG8_SB
#undef PG8_STAGE
#undef PG8_LDA
#undef PG8_LDB
#undef PG8_MMA
#undef PG8_WAIT_V
#undef PG8_WAIT_L
#undef PG8_BAR
#undef PG8_SCHED
}
}

#define LAS __attribute__((address_space(3)))
using pg8::bf16_t; using pg8::bf16x8; using pg8::f32x4; using pg8::u32x4; using pg8::Unit;
typedef float f32x16 __attribute__((ext_vector_type(16)));
typedef short s16x4 __attribute__((ext_vector_type(4)));
typedef float f32x2v __attribute__((ext_vector_type(2)));
typedef __bf16 bf16x2v __attribute__((ext_vector_type(2)));
#define DI __device__ __forceinline__
#define LDS_WAIT() asm volatile("s_waitcnt lgkmcnt(0)" ::: "memory")

constexpr int DM = 1024, NP = 32768, NS = 1024, MT = NP + NS, MEMR = 2048, MA = MT + MEMR, DFF = 2816, NQKV = 3072;
constexpr float EPS = 1e-6f, LOG2E = 1.44269504088896f;
constexpr float QSCALE = 0.125f * LOG2E;
constexpr size_t OFF_Y = 0;
constexpr size_t OFF_AK_P = 34603008, OFF_AV_P = 36700160, OFF_BK_P = 38797312, OFF_BV_P = 55574528, OFF_BL_P = 72351744;
constexpr size_t OFF_MK_P = 72613888, OFF_MV_P = 74711040, OFF_CV_P = 76808192;
constexpr size_t OFF_AK_S = 76853248, OFF_AV_S = 77377536, OFF_BK_S = 77901824, OFF_BV_S = 78426112, OFF_BL_S = 78950400, OFF_CV_S = 78958592;
constexpr size_t OUT_TOTAL = 79048704;
constexpr size_t MiB = 1u << 20;
constexpr size_t WS_WIN = 0, WS_WO = 10 * MiB, WS_WMQ = 12 * MiB, WS_WMO = 14 * MiB, WS_WUP = 16 * MiB, WS_WDN = 28 * MiB;
constexpr size_t WS_RSTD1 = 34 * MiB, WS_SS2 = 34 * MiB + 256 * 1024, WS_SS3 = 34 * MiB + 512 * 1024, WS_CTR = 34 * MiB + 768 * 1024;
constexpr size_t WS_GTAB = 34 * MiB + 800 * 1024;
constexpr size_t WS_CUMP = 35 * MiB, WS_CUMS = 36 * MiB;
constexpr size_t WS_MK = 40 * MiB, WS_MV = 52 * MiB, WS_MEMRAW = 64 * MiB;
constexpr size_t WS_XB = 80 * MiB, WS_P = 150 * MiB, WS_O = 348 * MiB;
constexpr size_t WS_X1B = 80 * MiB, WS_QM = 146 * MiB, WS_OM = 212 * MiB, WS_X2B = 278 * MiB;
constexpr size_t WS_AB = 80 * MiB, WS_SIDE = 348 * MiB;
constexpr size_t SIDE_ELEMS = (size_t)528 * 2 * DFF;
constexpr size_t WS_END = 414 * MiB;
constexpr int LDS_BYTES = 143360 + 256;
constexpr int LDS_NEXT = 143360;

struct Params { const float* in[32]; float* out; unsigned char* ws; };

DI unsigned pk2(float lo, float hi) { f32x2v v = {lo, hi}; bf16x2v b = __builtin_convertvector(v, bf16x2v); return __builtin_bit_cast(unsigned, b); }
DI float bf2f(unsigned short s) { return __uint_as_float(((unsigned)s) << 16); }
DI float wave_sum(float v) {
#pragma unroll
    for (int o = 1; o < 64; o <<= 1) v += __shfl_xor(v, o);
    return v;
}
DI u32x4 pack8(const f32x4& a, const f32x4& b) { u32x4 w; w.x = pk2(a[0], a[1]); w.y = pk2(a[2], a[3]); w.z = pk2(b[0], b[1]); w.w = pk2(b[2], b[3]); return w; }

DI void transpose_item(const float* W, int ldw, int K, const float* gk, bf16_t* WT, int destrow0, int k0, int n0, LAS float* scr, int lane) {
#pragma unroll 8
    for (int i = 0; i < 32; ++i) { const int kk = 2 * i + (lane >> 5); float v = W[(size_t)(k0 + kk) * ldw + n0 + (lane & 31)]; if (gk) v *= gk[k0 + kk]; scr[kk * 33 + (lane & 31)] = v; }
    LDS_WAIT(); asm volatile("" ::: "memory");
    const int c = lane & 7;
#pragma unroll
    for (int j = 0; j < 4; ++j) { const int n = (lane >> 3) + 8 * j; const LAS float* s = scr + (8 * c) * 33 + n;
        u32x4 o; o.x = pk2(s[0 * 33], s[1 * 33]); o.y = pk2(s[2 * 33], s[3 * 33]); o.z = pk2(s[4 * 33], s[5 * 33]); o.w = pk2(s[6 * 33], s[7 * 33]);
        *(u32x4*)(WT + (size_t)(destrow0 + n) * K + k0 + 8 * c) = o; }
    LDS_WAIT(); asm volatile("" ::: "memory");
}

DI void p0_prologue(const Params& p, LAS unsigned char* lds, int tid) {
    const int lane = tid & 63, wave = tid >> 6, G = gridDim.x;
    const int gw = blockIdx.x * 8 + wave, NGW = G * 8;
    const int gt = blockIdx.x * 512 + tid, NGT = G * 512;
    unsigned char* ws = p.ws;
    { float* ss2 = (float*)(ws + WS_SS2); float* ss3 = (float*)(ws + WS_SS3);
      for (int i = gt; i < MT; i += NGT) { ss2[i] = 0.f; ss3[i] = 0.f; }
      if (gt < 64) ((unsigned*)(ws + WS_CTR))[gt] = 0u;
      if (gt < 384) { const int ty = gt >> 6, d = gt & 63; ((float*)(ws + WS_GTAB))[gt] = ty == 0 ? p.in[13][d] : ty == 1 ? p.in[14][d] : ty == 3 ? p.in[16][d] : ty == 4 ? p.in[17][d] : 1.f; } }
    LAS float* wfl = (LAS float*)(lds + 73728);
    { const float* w_in = p.in[11]; const float* g1 = p.in[19];
      for (int e = tid; e < 8192; e += 512) { const int c = e >> 10, k = e & 1023; wfl[e] = w_in[(size_t)k * 3080 + 3072 + c] * g1[k]; } }
    __syncthreads();
    LAS float* scr = (LAS float*)(lds + wave * 8448);
    {
        constexpr int I_IN = 16 * 96, I_MKV = 16 * 64, I_SQ = 16 * 32, I_UP = 16 * 176, I_DN = 44 * 32;
        constexpr int NITEMS = I_IN + I_MKV + 3 * I_SQ + I_UP + I_DN;
        bf16_t* WTin = (bf16_t*)(ws + WS_WIN);
        for (int it = gw; it < NITEMS; it += NGW) {
            int r = it;
            if (r < I_IN) { const int kb = r / 96, nb = r % 96, n0 = 32 * nb;
                const int T = n0 >> 8, wc = (n0 >> 6) & 3, bj = (n0 >> 5) & 1;
                transpose_item(p.in[11], 3080, 1024, p.in[19], WTin, 256 * T + 128 * bj + 32 * wc, 64 * kb, n0, scr, lane); continue; } r -= I_IN;
            if (r < I_MKV) { const int kb = r / 64, nb = r % 64; transpose_item(p.in[23], 2048, 1024, p.in[21], WTin, 3072 + 32 * nb, 64 * kb, 32 * nb, scr, lane); continue; } r -= I_MKV;
            if (r < I_SQ) { const int kb = r / 32, nb = r % 32; transpose_item(p.in[18], 1024, 1024, nullptr, (bf16_t*)(ws + WS_WO), 32 * nb, 64 * kb, 32 * nb, scr, lane); continue; } r -= I_SQ;
            if (r < I_SQ) { const int kb = r / 32, nb = r % 32; transpose_item(p.in[22], 1024, 1024, p.in[20], (bf16_t*)(ws + WS_WMQ), 32 * nb, 64 * kb, 32 * nb, scr, lane); continue; } r -= I_SQ;
            if (r < I_SQ) { const int kb = r / 32, nb = r % 32; transpose_item(p.in[26], 1024, 1024, nullptr, (bf16_t*)(ws + WS_WMO), 32 * nb, 64 * kb, 32 * nb, scr, lane); continue; } r -= I_SQ;
            if (r < I_UP) { const int kb = r / 176, nb = r % 176, n0 = 32 * nb;
                const int dest = (n0 < DFF) ? 256 * (n0 >> 7) + (n0 & 127) : 256 * ((n0 - DFF) >> 7) + 128 + ((n0 - DFF) & 127);
                transpose_item(p.in[28], 2 * DFF, 1024, p.in[27], (bf16_t*)(ws + WS_WUP), dest, 64 * kb, n0, scr, lane); continue; } r -= I_UP;
            { const int kb = r / 32, nb = r % 32; transpose_item(p.in[31], 1024, DFF, nullptr, (bf16_t*)(ws + WS_WDN), 32 * nb, 64 * kb, 32 * nb, scr, lane); }
        }
    }
    {
        bf16_t* XB = (bf16_t*)(ws + WS_XB); float* rstd1 = (float*)(ws + WS_RSTD1);
        const float* bfv = p.in[12];
        for (int row = gw; row < MA; row += NGW) {
            const float* src = row < NP ? p.in[0] + (size_t)row * DM : (row < MT ? p.in[1] + (size_t)(row - NP) * DM : p.in[10] + (size_t)(row - MT) * DM);
            f32x4 v[4]; float ss = 0.f;
#pragma unroll
            for (int j = 0; j < 4; ++j) { v[j] = ((const f32x4*)src)[lane + 64 * j]; ss += (v[j][0] * v[j][0] + v[j][1] * v[j][1]) + (v[j][2] * v[j][2] + v[j][3] * v[j][3]); }
            ss = wave_sum(ss);
            const float rstd = rsqrtf(ss * (1.f / DM) + EPS);
            unsigned long long* o8 = (unsigned long long*)(XB + (size_t)row * DM) + lane;
#pragma unroll
            for (int j = 0; j < 4; ++j) o8[64 * j] = (unsigned long long)pk2(v[j][0], v[j][1]) | ((unsigned long long)pk2(v[j][2], v[j][3]) << 32);
            if (lane == 0) rstd1[row] = rstd;
            if (row < MT) {
                float a0 = 0.f, a1 = 0.f, a2 = 0.f, a3 = 0.f, a4 = 0.f, a5 = 0.f, a6 = 0.f, a7 = 0.f;
#pragma unroll
                for (int j = 0; j < 4; ++j) {
                    const int k4 = lane + 64 * j; const LAS f32x4* wp = (const LAS f32x4*)wfl + k4; f32x4 w;
#define FDOT(acc_, c_) w = wp[256 * c_]; acc_ += (v[j][0] * w[0] + v[j][1] * w[1]) + (v[j][2] * w[2] + v[j][3] * w[3]);
                    FDOT(a0, 0) FDOT(a1, 1) FDOT(a2, 2) FDOT(a3, 3) FDOT(a4, 4) FDOT(a5, 5) FDOT(a6, 6) FDOT(a7, 7)
#undef FDOT
                }
                a0 = wave_sum(a0); a1 = wave_sum(a1); a2 = wave_sum(a2); a3 = wave_sum(a3); a4 = wave_sum(a4); a5 = wave_sum(a5); a6 = wave_sum(a6); a7 = wave_sum(a7);
                if (lane < 8) {
                    float a = lane == 0 ? a0 : lane == 1 ? a1 : lane == 2 ? a2 : lane == 3 ? a3 : lane == 4 ? a4 : lane == 5 ? a5 : lane == 6 ? a6 : a7;
                    const float z = a * rstd + bfv[lane];
                    const float lf = fminf(z, 0.f) - log1pf(expf(-fabsf(z)));
                    float* dst = row < NP ? p.out + OFF_BL_P + (size_t)row * 8 : p.out + OFF_BL_S + (size_t)(row - NP) * 8;
                    dst[lane] = lf;
                }
            }
        }
    }
    {
        const f32x4* ck = (const f32x4*)p.in[7]; const f32x4* cv = (const f32x4*)p.in[8]; const f32x4* gq = (const f32x4*)p.in[24];
        unsigned long long* mk = (unsigned long long*)(ws + WS_MK) + (size_t)8 * 256 * 1024 / 4;
        unsigned long long* mv = (unsigned long long*)(ws + WS_MV) + (size_t)8 * 256 * 1024 / 4;
        for (int i = gt; i < 16 * 256 * 1024 / 4; i += NGT) {
            const f32x4 g = gq[i & 63]; f32x4 k = ck[i]; const f32x4 v = cv[i]; k = k * g;
            mk[i] = (unsigned long long)pk2(k[0], k[1]) | ((unsigned long long)pk2(k[2], k[3]) << 32);
            mv[i] = (unsigned long long)pk2(v[0], v[1]) | ((unsigned long long)pk2(v[2], v[3]) << 32);
        }
    }
    __syncthreads();
}

struct DualOrder {
    int n1, G, c, nM2, n2, pm_off, pn_off, nM, nN;
    DI bool next(int i, Unit& u) const {
        long L = (long)i * G + c;
        if (L < n1) {
            int wgid = (int)L; { const int q = n1 / 8, xcd = wgid % 8, off = wgid / 8; wgid = xcd * q + off; }
            const int nig = 8 * nN, gid = wgid / nig, fm = gid * 8, gsz = (nM - fm) < 8 ? (nM - fm) : 8;
            u.pm = fm + ((wgid % nig) % gsz); u.pn = (wgid % nig) / gsz; return true;
        }
        L -= n1; if (L >= n2) return false;
        u.pm = pm_off + (int)(L % nM2); u.pn = pn_off + (int)(L / nM2); return true;
    }
    DI void a_ready(const Unit&) const {}
    DI void done(const Unit&) const {}
};

struct EpiInProj {
    static constexpr bool PERM = true, AFTER_DRAIN = false;
    const float* rstd1; bf16_t* P; float* out; float* memraw; const float* gtab;
    DI void operator()(const f32x4 (&acc)[2][2][4][2], const Unit& u, int wr, int wc, int fr, int fq) const {
        if (u.pn >= 12) {
#pragma unroll
            for (int ai = 0; ai < 2; ++ai)
#pragma unroll
                for (int m = 0; m < 4; ++m) { const int row = u.pm * 256 + ai * 128 + wr * 64 + m * 16 + fr; const float rs = rstd1[row];
                    float* dst = memraw + (size_t)(row - MT) * 2048 + (u.pn - 12) * 256 + wc * 32 + 8 * fq;
#pragma unroll
                    for (int bj = 0; bj < 2; ++bj) { *(f32x4*)(dst + bj * 128) = acc[ai][bj][m][0] * rs; *(f32x4*)(dst + bj * 128 + 4) = acc[ai][bj][m][1] * rs; } }
            return;
        }
        const int type = u.pn >> 1, head = 4 * (u.pn & 1) + wc;
        const bool isq = (type == 0 || type == 3), isk = (type == 1 || type == 4);
        const float* g = gtab + type * 64;
        f32x4 gv[2][2];
#pragma unroll
        for (int bj = 0; bj < 2; ++bj)
#pragma unroll
            for (int n = 0; n < 2; ++n) gv[bj][n] = *(const f32x4*)(g + 32 * bj + 8 * fq + 4 * n);
#pragma unroll
        for (int ai = 0; ai < 2; ++ai)
#pragma unroll
            for (int m = 0; m < 4; ++m) {
                const int row = u.pm * 256 + ai * 128 + wr * 64 + m * 16 + fr; const float rs = rstd1[row];
                f32x4 v[2][2];
#pragma unroll
                for (int bj = 0; bj < 2; ++bj)
#pragma unroll
                    for (int n = 0; n < 2; ++n) v[bj][n] = acc[ai][bj][m][n] * rs;
                if (isq || isk) {
                    float ss = 0.f;
#pragma unroll
                    for (int bj = 0; bj < 2; ++bj)
#pragma unroll
                        for (int n = 0; n < 2; ++n) ss += (v[bj][n][0] * v[bj][n][0] + v[bj][n][1] * v[bj][n][1]) + (v[bj][n][2] * v[bj][n][2] + v[bj][n][3] * v[bj][n][3]);
                    ss += __shfl_xor(ss, 16); ss += __shfl_xor(ss, 32);
                    float r = rsqrtf(ss * (1.f / 64.f) + EPS); if (isq) r *= QSCALE;
#pragma unroll
                    for (int bj = 0; bj < 2; ++bj)
#pragma unroll
                        for (int n = 0; n < 2; ++n) v[bj][n] = v[bj][n] * r * gv[bj][n];
                }
                bf16_t* prow = P + (size_t)row * NQKV + type * 512 + head * 64 + 8 * fq;
#pragma unroll
                for (int bj = 0; bj < 2; ++bj) *(u32x4*)(prow + 32 * bj) = pack8(v[bj][0], v[bj][1]);
                if (!isq) {
                    float* dst = nullptr;
                    if (row < NP) { const int b = row >> 12, t = row & 4095;
                        if (type <= 2) { if (t >= 3584) dst = out + (type == 1 ? OFF_AK_P : OFF_AV_P) + ((size_t)(b * 512 + t - 3584) * 8 + head) * 64; }
                        else dst = out + (type == 4 ? OFF_BK_P : OFF_BV_P) + ((size_t)row * 8 + head) * 64; }
                    else { const int rs_ = row - NP;
                        dst = out + (type == 1 ? OFF_AK_S : type == 2 ? OFF_AV_S : type == 4 ? OFF_BK_S : OFF_BV_S) + ((size_t)rs_ * 8 + head) * 64; }
                    if (dst) {
#pragma unroll
                        for (int bj = 0; bj < 2; ++bj) { *(f32x4*)(dst + 32 * bj + 8 * fq) = v[bj][0]; *(f32x4*)(dst + 32 * bj + 8 * fq + 4) = v[bj][1]; } }
                }
            }
    }
};

struct EpiRes {
    static constexpr bool PERM = true, AFTER_DRAIN = false;
    const float* src_p; const float* src_s; float* out; bf16_t* XB; float* ss;
    DI void operator()(const f32x4 (&acc)[2][2][4][2], const Unit& u, int wr, int wc, int fr, int fq) const {
#pragma unroll
        for (int ai = 0; ai < 2; ++ai)
#pragma unroll
            for (int m = 0; m < 4; ++m) {
                const int row = u.pm * 256 + ai * 128 + wr * 64 + m * 16 + fr;
                const float* src = row < NP ? src_p + (size_t)row * DM : src_s + (size_t)(row - NP) * DM;
                float sq = 0.f;
#pragma unroll
                for (int bj = 0; bj < 2; ++bj) { const int col = u.pn * 256 + bj * 128 + wc * 32 + 8 * fq;
                    const f32x4 v0 = *(const f32x4*)(src + col) + acc[ai][bj][m][0], v1 = *(const f32x4*)(src + col + 4) + acc[ai][bj][m][1];
                    *(f32x4*)(out + (size_t)row * DM + col) = v0; *(f32x4*)(out + (size_t)row * DM + col + 4) = v1;
                    *(u32x4*)(XB + (size_t)row * DM + col) = pack8(v0, v1);
                    sq += (v0[0] * v0[0] + v0[1] * v0[1]) + (v0[2] * v0[2] + v0[3] * v0[3]) + (v1[0] * v1[0] + v1[1] * v1[1]) + (v1[2] * v1[2] + v1[3] * v1[3]); }
                sq += __shfl_xor(sq, 16); sq += __shfl_xor(sq, 32);
                if (fq == 0) atomicAdd(ss + row, sq);
            }
    }
};
struct EpiScaleBf16 {
    static constexpr bool PERM = true, AFTER_DRAIN = false;
    const float* ss; bf16_t* O;
    DI void operator()(const f32x4 (&acc)[2][2][4][2], const Unit& u, int wr, int wc, int fr, int fq) const {
#pragma unroll
        for (int ai = 0; ai < 2; ++ai)
#pragma unroll
            for (int m = 0; m < 4; ++m) {
                const int row = u.pm * 256 + ai * 128 + wr * 64 + m * 16 + fr; const float rs = rsqrtf(ss[row] * (1.f / DM) + EPS);
#pragma unroll
                for (int bj = 0; bj < 2; ++bj) { const int col = u.pn * 256 + bj * 128 + wc * 32 + 8 * fq;
                    *(u32x4*)(O + (size_t)row * DM + col) = pack8(acc[ai][bj][m][0] * rs, acc[ai][bj][m][1] * rs); }
            }
    }
};
DI f32x4 silu_mul(const f32x4& c, const f32x4& v) { f32x4 r;
#pragma unroll
    for (int e = 0; e < 4; ++e) r[e] = c[e] / (1.f + __expf(-c[e])) * v[e];
    return r; }
struct EpiUp {
    static constexpr bool PERM = true, AFTER_DRAIN = false;
    const float* ss3; const float* wconv; const float* bconv; bf16_t* Ab; float* gfirst; float* vfirst; float* glast;
    DI void operator()(const f32x4 (&acc)[2][2][4][2], const Unit& u, int wr, int wc, int fr, int fq) const {
        const int col0 = u.pn * 128 + wc * 32 + 8 * fq, lane = threadIdx.x & 63;
        const int s1 = (lane & ~15) | ((lane - 1) & 15), s2 = (lane & ~15) | ((lane - 2) & 15);
        f32x4 w0[2], w1[2], w2[2], bc[2];
#pragma unroll
        for (int n = 0; n < 2; ++n) { w0[n] = *(const f32x4*)(wconv + col0 + 4 * n); w1[n] = *(const f32x4*)(wconv + DFF + col0 + 4 * n); w2[n] = *(const f32x4*)(wconv + 2 * DFF + col0 + 4 * n); bc[n] = *(const f32x4*)(bconv + col0 + 4 * n); }
#pragma unroll
        for (int ai = 0; ai < 2; ++ai) {
            const int blk = u.pm * 4 + ai * 2 + wr;
            f32x4 pR1[2], pR2[2];
#pragma unroll
            for (int n = 0; n < 2; ++n) { pR1[n] = (f32x4){0.f, 0.f, 0.f, 0.f}; pR2[n] = pR1[n]; }
#pragma unroll
            for (int m = 0; m < 4; ++m) {
                const int row = u.pm * 256 + ai * 128 + wr * 64 + m * 16 + fr; const float rs = rsqrtf(ss3[row] * (1.f / DM) + EPS);
                f32x4 a[2];
#pragma unroll
                for (int n = 0; n < 2; ++n) {
                    const f32x4 g = acc[ai][0][m][n] * rs, vv = acc[ai][1][m][n] * rs; f32x4 R1, R2;
#pragma unroll
                    for (int e = 0; e < 4; ++e) { R1[e] = __shfl(g[e], s1); R2[e] = __shfl(g[e], s2); }
                    const f32x4 p1 = fr >= 1 ? R1 : pR1[n], p2 = fr >= 2 ? R2 : pR2[n];
                    const f32x4 cv = p2 * w0[n] + p1 * w1[n] + g * w2[n] + bc[n];
                    a[n] = silu_mul(cv, vv);
                    pR1[n] = R1; pR2[n] = R2;
                    if (m == 0 && fr < 2) { *(f32x4*)(gfirst + ((size_t)blk * 2 + fr) * DFF + col0 + 4 * n) = g; *(f32x4*)(vfirst + ((size_t)blk * 2 + fr) * DFF + col0 + 4 * n) = vv; }
                    if (m == 3 && fr >= 14) *(f32x4*)(glast + ((size_t)blk * 2 + fr - 14) * DFF + col0 + 4 * n) = g;
                }
                if (!(m == 0 && fr < 2)) *(u32x4*)(Ab + (size_t)row * DFF + col0) = pack8(a[0], a[1]);
            }
        }
    }
};
struct EpiDown {
    static constexpr bool PERM = true, AFTER_DRAIN = false;
    float* out;
    DI void operator()(const f32x4 (&acc)[2][2][4][2], const Unit& u, int wr, int wc, int fr, int fq) const {
#pragma unroll
        for (int ai = 0; ai < 2; ++ai)
#pragma unroll
            for (int m = 0; m < 4; ++m) {
                const int row = u.pm * 256 + ai * 128 + wr * 64 + m * 16 + fr;
#pragma unroll
                for (int bj = 0; bj < 2; ++bj) { float* o = out + (size_t)row * DM + u.pn * 256 + bj * 128 + wc * 32 + 8 * fq;
                    *(f32x4*)o = *(const f32x4*)o + acc[ai][bj][m][0]; *(f32x4*)(o + 4) = *(const f32x4*)(o + 4) + acc[ai][bj][m][1]; }
            }
    }
};

DI void cumsum_batch(const Params& p, LAS unsigned char* lds, int tid, int beta) {
    LAS float* seg = (LAS float*)lds;
    const int h = tid & 7, sg = tid >> 3;
    const bool sample = beta >= 8; const int b = sample ? beta - 8 : beta;
    const int L = sample ? 65 : 64, T = sample ? 4160 : 4096;
    const float* lf_new = sample ? p.out + OFF_BL_S + (size_t)b * 64 * 8 : p.out + OFF_BL_P + (size_t)b * 4096 * 8;
    const float* lf_cache = p.in[6] + (size_t)b * 4096 * 8;
    float* dst = sample ? (float*)(p.ws + WS_CUMS) + ((size_t)b * 8 + h) * 4160 : (float*)(p.ws + WS_CUMP) + ((size_t)b * 8 + h) * 4096;
    float s = 0.f;
    for (int i = 0; i < L; ++i) { const int t = sg * L + i; const float v = sample ? (t < 4096 ? lf_cache[(size_t)t * 8 + h] : lf_new[(size_t)(t - 4096) * 8 + h]) : lf_new[(size_t)t * 8 + h]; s += v; }
    seg[sg * 8 + h] = s;
    __syncthreads();
    float pre = 0.f;
    for (int j = 0; j < sg; ++j) pre += seg[j * 8 + h];
    s = pre;
    for (int i = 0; i < L; ++i) { const int t = sg * L + i; const float v = sample ? (t < 4096 ? lf_cache[(size_t)t * 8 + h] : lf_new[(size_t)(t - 4096) * 8 + h]) : lf_new[(size_t)t * 8 + h]; s += v; dst[t] = s; }
    (void)T;
    __syncthreads();
}

struct AttnArgs {
    const bf16_t* Q; int qstride; int nq; int qpos0; int kt_lo, kt_hi;
    const float* k32; const float* v32; int stride32; int n32;
    const bf16_t* k16; const bf16_t* v16; int stride16;
    bf16_t* O; int ostride;
    const float* cum; const float* tab;
};
DI f32x16 mfma32(bf16x8 a, bf16x8 b, f32x16 c) { return __builtin_amdgcn_mfma_f32_32x32x16_bf16(a, b, c, 0, 0, 0); }
typedef short v4i16_t __attribute__((ext_vector_type(4)));
DI s16x4 vtr(const LAS unsigned char* p) { return __builtin_bit_cast(s16x4, __builtin_amdgcn_ds_read_tr16_b64_v4i16((LAS v4i16_t*)p)); }

template <int D, int MODE, bool F32, int DV>
DI void attn_unit(LAS unsigned char* lds, const AttnArgs& a, int tid, int vcol0) {
    constexpr int KSTR = D * 2 + 16, TILE = 64 * KSTR, NCH = D / 8, PER = (64 * NCH) / 512;
    constexpr int VSTR = DV == 64 ? 144 : 288, VTILE = 64 * VSTR, NCHV = DV / 8, PERV = (64 * NCHV) / 512, BUFB = TILE + VTILE;
    constexpr int CUM_OFF = 2 * BUFB, TAB_OFF = CUM_OFF + 512;
    const int lane = tid & 63, w = __builtin_amdgcn_readfirstlane(tid >> 6), r = lane & 31, h = lane >> 5;
    const bool wact = 32 * w < a.nq;
    const int qrow = 32 * w + r, qpos = a.qpos0 + qrow, qw0 = a.qpos0 + 32 * w;
    int w_lo, w_hi;
    if (MODE == 0) { const int c = qw0 >> 6; w_lo = c - 8 < 0 ? 0 : c - 8; w_hi = c; }
    else if (MODE == 1) { w_lo = 0; w_hi = qw0 >> 6; }
    else { w_lo = a.kt_lo; w_hi = a.kt_hi; }
    if (!wact) { w_lo = 1; w_hi = 0; }
    bf16x8 qf[D / 16];
    {
        const bf16_t* qp = a.Q + (size_t)(wact ? qrow : 0) * a.qstride + 8 * h;
#pragma unroll
        for (int kk = 0; kk < D / 16; ++kk) qf[kk] = *(const bf16x8*)(qp + 16 * kk);
    }
    float sc = 1.f;
    if (MODE == 2) {
        float ss = 0.f;
#pragma unroll
        for (int kk = 0; kk < D / 16; ++kk)
#pragma unroll
            for (int j = 0; j < 8; ++j) { const float f = bf2f((unsigned short)qf[kk][j]); ss += f * f; }
        ss += __shfl_xor(ss, 32);
        sc = rsqrtf(ss * (1.f / 256.f) + EPS) * 0.0625f * LOG2E;
    }
    float ct2 = 0.f;
    if (MODE == 1) ct2 = a.cum[wact ? qpos : a.qpos0] * LOG2E;
    LAS float* tabl = (LAS float*)(lds + TAB_OFF);
    if (MODE == 0) { if (tid < 257) tabl[tid] = a.tab[tid] * LOG2E; }
    f32x16 o[DV / 32];
#pragma unroll
    for (int n = 0; n < DV / 32; ++n)
#pragma unroll
        for (int i = 0; i < 16; ++i) o[n][i] = 0.f;
    float mrun = -1e30f, lrun = 0.f;

    u32x4 kr[PER], vr[PERV]; f32x4 kr2 = {0.f,0.f,0.f,0.f}, vr2 = kr2, kr3 = kr2, vr3 = kr2; bool was32 = false; float cumr = 0.f;
    constexpr int RPK = 512 / NCH, RPV = 512 / NCHV;
    const unsigned voffK = (unsigned)((tid / NCH) * a.stride16 + 8 * (tid % NCH)) * 2u, voffV = (unsigned)((tid / NCHV) * a.stride16 + 8 * (tid % NCHV)) * 2u;
    const unsigned voff32 = (unsigned)((tid >> 3) * a.stride32 + 8 * (tid & 7)) * 4u;
    const unsigned ldsK = (unsigned)((tid / NCH) * KSTR + 16 * (tid % NCH)), ldsV = (unsigned)(TILE + (tid / NCHV) * VSTR + 16 * (tid % NCHV));
#define ISSUE(KT) do { const int kt_ = (KT); \
        if (F32 && kt_ < a.n32) { was32 = true; \
            const char* kb32_ = (const char*)a.k32 + (size_t)(64 * kt_) * a.stride32 * 4; const char* vb32_ = (const char*)a.v32 + (size_t)(64 * kt_) * a.stride32 * 4; \
            kr3 = *(const f32x4*)(kb32_ + voff32); kr2 = *(const f32x4*)(kb32_ + voff32 + 16); vr3 = *(const f32x4*)(vb32_ + voff32); vr2 = *(const f32x4*)(vb32_ + voff32 + 16); } \
        else { was32 = false; \
            const char* kb16_ = (const char*)a.k16 + (size_t)(64 * (kt_ - a.n32)) * a.stride16 * 2; const char* vb16_ = (const char*)(a.v16 + vcol0) + (size_t)(64 * (kt_ - a.n32)) * a.stride16 * 2; \
            _Pragma("unroll") for (int j_ = 0; j_ < PER; ++j_) kr[j_] = *(const u32x4*)(kb16_ + (size_t)(j_ * RPK) * a.stride16 * 2 + voffK); \
            _Pragma("unroll") for (int j_ = 0; j_ < PERV; ++j_) vr[j_] = *(const u32x4*)(vb16_ + (size_t)(j_ * RPV) * a.stride16 * 2 + voffV); } \
        if (MODE == 1 && tid < 64) cumr = a.cum[64 * kt_ + tid]; } while (0)
#define WRITE(BUF) do { LAS unsigned char* kb_ = lds + (BUF) * BUFB; \
        if (F32 && was32) { *(LAS u32x4*)(kb_ + ldsK) = pack8(kr3, kr2); *(LAS u32x4*)(kb_ + ldsV) = pack8(vr3, vr2); } \
        else { _Pragma("unroll") for (int j_ = 0; j_ < PER; ++j_) *(LAS u32x4*)(kb_ + ldsK + j_ * RPK * KSTR) = kr[j_]; \
            _Pragma("unroll") for (int j_ = 0; j_ < PERV; ++j_) *(LAS u32x4*)(kb_ + ldsV + j_ * RPV * VSTR) = vr[j_]; } \
        if (MODE == 1 && tid < 64) ((LAS float*)(lds + CUM_OFF))[(BUF) * 64 + tid] = cumr * LOG2E; } while (0)

    const int rs23 = (r & ~12) | ((r & 4) << 1) | ((r & 8) >> 1);
    const int i16 = lane & 15, q_ = i16 >> 2, p_ = i16 & 3, g_ = (lane >> 4) & 1;
    ISSUE(a.kt_lo); WRITE(0); __syncthreads();
    int it = 0;
    for (int kt = a.kt_lo; kt <= a.kt_hi; ++kt, ++it) {
        const int buf = it & 1; const bool more = kt < a.kt_hi;
        if (D == 64 && more) ISSUE(kt + 1);
        if (kt >= w_lo && kt <= w_hi) {
            const LAS unsigned char* Kt = lds + buf * BUFB; const LAS unsigned char* Vt = Kt + TILE;
            const LAS float* cl = (const LAS float*)(lds + CUM_OFF) + buf * 64;
#pragma unroll
            for (int step = 0; step < 2; ++step) {
                const int kpos0 = 64 * kt + 32 * step;
                if (MODE == 1 && kpos0 > qw0) continue;
                f32x16 s;
#pragma unroll
                for (int i = 0; i < 16; ++i) s[i] = 0.f;
                const LAS unsigned char* kp = Kt + (32 * step + rs23) * KSTR + 16 * h;
#pragma unroll
                for (int kk = 0; kk < D / 16; ++kk) { const bf16x8 kf = *(const LAS bf16x8*)(kp + 32 * kk); s = mfma32(kf, qf[kk], s); if (D > 64 && (kk & 3) == 3) __builtin_amdgcn_sched_barrier(0); }
                if (MODE == 0) {
                    if (qw0 - (kpos0 + 31) >= 128) { const float cb = tabl[256];
#pragma unroll
                        for (int i = 0; i < 16; ++i) s[i] += cb; }
                    else {
#pragma unroll
                        for (int i = 0; i < 16; ++i) { int rel = qpos - (kpos0 + 16 * (i >> 3) + 8 * h + (i & 7)); rel = rel < -128 ? -128 : (rel > 128 ? 128 : rel); s[i] += tabl[rel + 128]; } }
                } else if (MODE == 1) {
                    const LAS f32x4* c4 = (const LAS f32x4*)(cl + 32 * step + 8 * h);
                    const f32x4 c0 = c4[0], c1 = c4[1], c2 = c4[4], c3 = c4[5];
#pragma unroll
                    for (int e = 0; e < 4; ++e) { s[e] += ct2 - c0[e]; s[4 + e] += ct2 - c1[e]; s[8 + e] += ct2 - c2[e]; s[12 + e] += ct2 - c3[e]; }
                    if (kpos0 == qw0) {
#pragma unroll
                        for (int i = 0; i < 16; ++i) if (16 * (i >> 3) + 8 * h + (i & 7) > r) s[i] = -1e30f; }
                } else {
#pragma unroll
                    for (int i = 0; i < 16; ++i) s[i] *= sc;
                }
                float mx = s[0];
#pragma unroll
                for (int i = 1; i < 16; ++i) mx = fmaxf(mx, s[i]);
                mx = fmaxf(mx, __shfl_xor(mx, 32));
                const float mnew = fmaxf(mrun, mx), alpha = __builtin_amdgcn_exp2f(mrun - mnew); mrun = mnew;
                float psum = 0.f;
#pragma unroll
                for (int i = 0; i < 16; ++i) { s[i] = __builtin_amdgcn_exp2f(s[i] - mnew); psum += s[i]; }
                lrun = lrun * alpha + psum;
#pragma unroll
                for (int n = 0; n < DV / 32; ++n)
#pragma unroll
                    for (int i = 0; i < 16; ++i) o[n][i] *= alpha;
                u32x4 pw0, pw1;
                pw0.x = pk2(s[0], s[1]); pw0.y = pk2(s[2], s[3]); pw0.z = pk2(s[4], s[5]); pw0.w = pk2(s[6], s[7]);
                pw1.x = pk2(s[8], s[9]); pw1.y = pk2(s[10], s[11]); pw1.z = pk2(s[12], s[13]); pw1.w = pk2(s[14], s[15]);
                const bf16x8 pf0 = __builtin_bit_cast(bf16x8, pw0), pf1 = __builtin_bit_cast(bf16x8, pw1);
                const LAS unsigned char* vb = Vt + (32 * step + 8 * h + q_) * VSTR + 32 * g_ + 8 * p_;
#pragma unroll
                for (int n = 0; n < DV / 32; ++n) {
                    { const s16x4 lo = vtr(vb + 64 * n), hi = vtr(vb + 4 * VSTR + 64 * n);
                      const bf16x8 vf = __builtin_shufflevector(lo, hi, 0, 1, 2, 3, 4, 5, 6, 7); o[n] = mfma32(vf, pf0, o[n]); }
                    { const s16x4 lo = vtr(vb + 16 * VSTR + 64 * n), hi = vtr(vb + 20 * VSTR + 64 * n);
                      const bf16x8 vf = __builtin_shufflevector(lo, hi, 0, 1, 2, 3, 4, 5, 6, 7); o[n] = mfma32(vf, pf1, o[n]); }
                }
            }
        }
        if (D > 64 && more) ISSUE(kt + 1);
        if (more) WRITE(buf ^ 1);
        __syncthreads();
    }
#undef ISSUE
#undef WRITE
    if (wact) {
        const float lt = lrun + __shfl_xor(lrun, 32), inv = 1.f / lt;
        bf16_t* op = a.O + vcol0 + (size_t)qrow * a.ostride + 4 * h;
#pragma unroll
        for (int n = 0; n < DV / 32; ++n)
#pragma unroll
            for (int i4 = 0; i4 < 4; ++i4) {
                const unsigned lo = pk2(o[n][4 * i4] * inv, o[n][4 * i4 + 1] * inv), hi = pk2(o[n][4 * i4 + 2] * inv, o[n][4 * i4 + 3] * inv);
                *(unsigned long long*)(op + 32 * n + 8 * i4) = (unsigned long long)lo | ((unsigned long long)hi << 32);
            }
    }
}

DI void memnorm_rows(const Params& p, int item, int tid) {
    const int lane = tid & 63, wave = tid >> 6;
    const float* raw = (const float*)(p.ws + WS_MEMRAW);
    bf16_t* MK = (bf16_t*)(p.ws + WS_MK); bf16_t* MV = (bf16_t*)(p.ws + WS_MV);
    const f32x4 gk = ((const f32x4*)p.in[25])[lane], gq = ((const f32x4*)p.in[24])[lane];
    for (int i = 0; i < 4; ++i) {
        const int row = item * 32 + wave * 4 + i; const float* rr = raw + (size_t)row * 2048;
#pragma unroll
        for (int hm = 0; hm < 4; ++hm) {
            f32x4 v = ((const f32x4*)(rr + hm * 256))[lane];
            float ss = (v[0] * v[0] + v[1] * v[1]) + (v[2] * v[2] + v[3] * v[3]); ss = wave_sum(ss);
            const float rs = rsqrtf(ss * (1.f / 256.f) + EPS);
            v = v * rs * gk;
            ((f32x4*)(p.out + OFF_MK_P + (size_t)row * 1024 + hm * 256))[lane] = v;
            const f32x4 vq = v * gq;
            ((unsigned long long*)(MK + (size_t)row * 1024 + hm * 256))[lane] = (unsigned long long)pk2(vq[0], vq[1]) | ((unsigned long long)pk2(vq[2], vq[3]) << 32);
            const f32x4 vv = ((const f32x4*)(rr + 1024 + hm * 256))[lane];
            ((f32x4*)(p.out + OFF_MV_P + (size_t)row * 1024 + hm * 256))[lane] = vv;
            ((unsigned long long*)(MV + (size_t)row * 1024 + hm * 256))[lane] = (unsigned long long)pk2(vv[0], vv[1]) | ((unsigned long long)pk2(vv[2], vv[3]) << 32);
        }
    }
}

DI int next_unit(LAS unsigned char* lds, unsigned* ctr, int tid) {
    LAS unsigned* nw = (LAS unsigned*)(lds + LDS_NEXT);
    if (tid == 0) *nw = atomicAdd(ctr, 1u);
    __syncthreads();
    const int u = (int)*nw;
    __syncthreads();
    return u;
}

DI void p2_attention(const Params& p, LAS unsigned char* lds, int tid) {
    unsigned* ctr = (unsigned*)(p.ws + WS_CTR);
    const bf16_t* P = (const bf16_t*)(p.ws + WS_P); bf16_t* Ob = (bf16_t*)(p.ws + WS_O);
    for (;;) {
        const int u = next_unit(lds, ctr, tid);
        if (u >= 2368) break;
        AttnArgs a; a.qstride = NQKV; a.stride16 = NQKV; a.ostride = DM; a.stride32 = 512; a.n32 = 0; a.k32 = nullptr; a.v32 = nullptr; a.cum = nullptr; a.tab = nullptr;
        if (u < 128) { const int b = u >> 3, h = u & 7; const size_t r0 = (size_t)(NP + 64 * b);
            a.Q = P + r0 * NQKV + 1536 + 64 * h; a.nq = 64; a.qpos0 = 4096; a.kt_lo = 0; a.kt_hi = 64; a.n32 = 64;
            a.k32 = p.in[4] + (size_t)b * 4096 * 512 + 64 * h; a.v32 = p.in[5] + (size_t)b * 4096 * 512 + 64 * h;
            a.k16 = P + r0 * NQKV + 2048 + 64 * h; a.v16 = P + r0 * NQKV + 2560 + 64 * h; a.O = Ob + r0 * DM + 512 + 64 * h;
            a.cum = (const float*)(p.ws + WS_CUMS) + ((size_t)b * 8 + h) * 4160;
            attn_unit<64, 1, true, 64>(lds, a, tid, 0);
        } else if (u < 1152) { const int v = u - 128, g = 15 - (v >> 6), b = (v & 63) >> 3, h = v & 7; const size_t r0 = (size_t)b * 4096;
            a.Q = P + (r0 + 256 * g) * NQKV + 1536 + 64 * h; a.nq = 256; a.qpos0 = 256 * g; a.kt_lo = 0; a.kt_hi = 4 * g + 3;
            a.k16 = P + r0 * NQKV + 2048 + 64 * h; a.v16 = P + r0 * NQKV + 2560 + 64 * h; a.O = Ob + (r0 + 256 * g) * DM + 512 + 64 * h;
            a.cum = (const float*)(p.ws + WS_CUMP) + ((size_t)b * 8 + h) * 4096;
            attn_unit<64, 1, false, 64>(lds, a, tid, 0);
        } else if (u < 2176) { const int v = u - 1152, g = v >> 6, b = (v & 63) >> 3, h = v & 7; const size_t r0 = (size_t)b * 4096;
            a.Q = P + (r0 + 256 * g) * NQKV + 64 * h; a.nq = 256; a.qpos0 = 256 * g; a.kt_lo = 4 * g - 8 < 0 ? 0 : 4 * g - 8; a.kt_hi = 4 * g + 3;
            a.k16 = P + r0 * NQKV + 512 + 64 * h; a.v16 = P + r0 * NQKV + 1024 + 64 * h; a.O = Ob + (r0 + 256 * g) * DM + 64 * h;
            a.tab = p.in[15] + h * 257;
            attn_unit<64, 0, false, 64>(lds, a, tid, 0);
        } else if (u < 2304) { const int v = u - 2176, b = v >> 3, h = v & 7; const size_t r0 = (size_t)(NP + 64 * b);
            a.Q = P + r0 * NQKV + 64 * h; a.nq = 64; a.qpos0 = 512; a.kt_lo = 0; a.kt_hi = 8; a.n32 = 8;
            a.k32 = p.in[2] + (size_t)b * 512 * 512 + 64 * h; a.v32 = p.in[3] + (size_t)b * 512 * 512 + 64 * h;
            a.k16 = P + r0 * NQKV + 512 + 64 * h; a.v16 = P + r0 * NQKV + 1024 + 64 * h; a.O = Ob + r0 * DM + 64 * h;
            a.tab = p.in[15] + h * 257;
            attn_unit<64, 0, true, 64>(lds, a, tid, 0);
        } else {
            memnorm_rows(p, u - 2304, tid);
        }
    }
}

DI void p5_mem_attention(const Params& p, LAS unsigned char* lds, int tid) {
    unsigned* ctr = (unsigned*)(p.ws + WS_CTR) + 16;
    const bf16_t* QM = (const bf16_t*)(p.ws + WS_QM); bf16_t* OM = (bf16_t*)(p.ws + WS_OM);
    const bf16_t* MK = (const bf16_t*)(p.ws + WS_MK); const bf16_t* MV = (const bf16_t*)(p.ws + WS_MV);
    for (;;) {
        const int u = next_unit(lds, ctr, tid);
        if (u >= 576) break;
        AttnArgs a; a.qstride = DM; a.stride16 = DM; a.ostride = DM; a.stride32 = 0; a.n32 = 0; a.k32 = nullptr; a.v32 = nullptr; a.cum = nullptr; a.tab = nullptr;
        a.qpos0 = 0; a.kt_lo = 0; a.kt_hi = 3;
        size_t r0; int kvb, hm;
        if (u < 512) { const int g = u & 15, b = u >> 6; hm = (u >> 4) & 3; r0 = (size_t)b * 4096 + 256 * g; kvb = b; a.nq = 256; }
        else { const int v = u - 512, b = v >> 2; hm = v & 3; r0 = (size_t)(NP + 64 * b); kvb = 8 + b; a.nq = 64; }
        a.Q = QM + r0 * DM + 256 * hm; a.O = OM + r0 * DM + 256 * hm;
        a.k16 = MK + (size_t)kvb * 256 * 1024 + 256 * hm; a.v16 = MV + (size_t)kvb * 256 * 1024 + 256 * hm;
        for (int vc = 0; vc < 256; vc += 64) attn_unit<256, 2, false, 64>(lds, a, tid, vc);
    }
}

DI void p8_fixup(const Params& p, int tid) {
    const int gt = blockIdx.x * 512 + tid, NGT = gridDim.x * 512;
    const float* gfirst = (const float*)(p.ws + WS_SIDE); const float* vfirst = gfirst + SIDE_ELEMS; const float* glast = vfirst + SIDE_ELEMS;
    bf16_t* Ab = (bf16_t*)(p.ws + WS_AB);
    const float* wconv = p.in[29]; const float* bconv = p.in[30]; const float* st = p.in[9];
    constexpr int C4 = DFF / 4;
    for (int idx = gt; idx < 528 * 2 * C4; idx += NGT) {
        const int c4 = idx % C4, bj = idx / C4, j = bj & 1, blk = bj >> 1, col = 4 * c4;
        const bool start = blk >= 512 || (blk & 63) == 0;
        f32x4 pa, pb;
        if (start) { if (blk >= 512) { const float* s = st + (size_t)(blk - 512) * 2 * DFF + col; pa = *(const f32x4*)s; pb = *(const f32x4*)(s + DFF); } else { pa = (f32x4){0.f, 0.f, 0.f, 0.f}; pb = pa; } }
        else { const float* s = glast + (size_t)(blk - 1) * 2 * DFF + col; pa = *(const f32x4*)s; pb = *(const f32x4*)(s + DFF); }
        const f32x4 g0 = *(const f32x4*)(gfirst + (size_t)blk * 2 * DFF + col), g1 = *(const f32x4*)(gfirst + ((size_t)blk * 2 + 1) * DFF + col);
        const f32x4 gm2 = j == 0 ? pa : pb, gm1 = j == 0 ? pb : g0, gc = j == 0 ? g0 : g1;
        const f32x4 vv = *(const f32x4*)(vfirst + ((size_t)blk * 2 + j) * DFF + col);
        const f32x4 cv = gm2 * *(const f32x4*)(wconv + col) + gm1 * *(const f32x4*)(wconv + DFF + col) + gc * *(const f32x4*)(wconv + 2 * DFF + col) + *(const f32x4*)(bconv + col);
        const f32x4 a = silu_mul(cv, vv);
        *(unsigned long long*)(Ab + (size_t)(blk * 64 + j) * DFF + col) = (unsigned long long)pk2(a[0], a[1]) | ((unsigned long long)pk2(a[2], a[3]) << 32);
    }
    for (int idx = gt; idx < 24 * 2 * C4; idx += NGT) {
        const int c4 = idx % C4, bj = idx / C4, j = bj & 1, b = bj >> 1, col = 4 * c4;
        const int blk = b < 8 ? 64 * b + 63 : 512 + (b - 8);
        const f32x4 g = *(const f32x4*)(glast + ((size_t)blk * 2 + j) * DFF + col);
        float* dst = b < 8 ? p.out + OFF_CV_P + ((size_t)b * 2 + j) * DFF + col : p.out + OFF_CV_S + ((size_t)(b - 8) * 2 + j) * DFF + col;
        *(f32x4*)dst = g;
    }
}

__global__ void __launch_bounds__(512, 2) mega_fwd(Params p) {
    extern __shared__ __attribute__((aligned(16))) unsigned char lds_raw[];
    LAS unsigned char* lds = (LAS unsigned char*)lds_raw;
    cg::grid_group grid = cg::this_grid();
    const int tid = threadIdx.x, G = gridDim.x;
    unsigned char* ws = p.ws;

#ifndef PM
#define PM 0x3ff
#endif
    if constexpr (PM & 1) p0_prologue(p, lds, tid);
    grid.sync();
    if constexpr ((PM >> 1) & 1) {
        pg8::Gemm g{(const bf16_t*)(ws + WS_XB), (const bf16_t*)(ws + WS_WIN), MA, 5120, 1024};
        DualOrder S; S.nM = 132; S.nN = 12; S.n1 = 132 * 12; S.G = G; S.c = (int)blockIdx.x; S.nM2 = 8; S.n2 = 64; S.pm_off = 132; S.pn_off = 12;
        EpiInProj E{(const float*)(ws + WS_RSTD1), (bf16_t*)(ws + WS_P), p.out, (float*)(ws + WS_MEMRAW), (const float*)(ws + WS_GTAB)};
        pg8::gemm_phase<EpiInProj, DualOrder, true, true>(lds, g, S, E);
        if (blockIdx.x < 24) cumsum_batch(p, lds, tid, (int)blockIdx.x);
    }
    grid.sync();
    if constexpr ((PM >> 2) & 1) p2_attention(p, lds, tid);
    grid.sync();
    if constexpr ((PM >> 3) & 1) {
        pg8::Gemm g{(const bf16_t*)(ws + WS_O), (const bf16_t*)(ws + WS_WO), MT, 1024, 1024};
        pg8::StaticOrder S; S.init(MT, 1024, G, (int)blockIdx.x);
        EpiRes E{p.in[0], p.in[1], p.out, (bf16_t*)(ws + WS_X1B), (float*)(ws + WS_SS2)};
        pg8::gemm_phase<EpiRes, pg8::StaticOrder, true, true>(lds, g, S, E);
    }
    grid.sync();
    if constexpr ((PM >> 4) & 1) {
        pg8::Gemm g{(const bf16_t*)(ws + WS_X1B), (const bf16_t*)(ws + WS_WMQ), MT, 1024, 1024};
        pg8::StaticOrder S; S.init(MT, 1024, G, (int)blockIdx.x);
        EpiScaleBf16 E{(const float*)(ws + WS_SS2), (bf16_t*)(ws + WS_QM)};
        pg8::gemm_phase<EpiScaleBf16, pg8::StaticOrder, true, true>(lds, g, S, E);
    }
    grid.sync();
    if constexpr ((PM >> 5) & 1) p5_mem_attention(p, lds, tid);
    grid.sync();
    if constexpr ((PM >> 6) & 1) {
        pg8::Gemm g{(const bf16_t*)(ws + WS_OM), (const bf16_t*)(ws + WS_WMO), MT, 1024, 1024};
        pg8::StaticOrder S; S.init(MT, 1024, G, (int)blockIdx.x);
        EpiRes E{p.out, p.out + (size_t)NP * DM, p.out, (bf16_t*)(ws + WS_X2B), (float*)(ws + WS_SS3)};
        pg8::gemm_phase<EpiRes, pg8::StaticOrder, true, true>(lds, g, S, E);
    }
    grid.sync();
    if constexpr ((PM >> 7) & 1) {
        pg8::Gemm g{(const bf16_t*)(ws + WS_X2B), (const bf16_t*)(ws + WS_WUP), MT, 2 * DFF, 1024};
        pg8::StaticOrder S; S.init(MT, 2 * DFF, G, (int)blockIdx.x);
        float* side = (float*)(ws + WS_SIDE);
        EpiUp E{(const float*)(ws + WS_SS3), p.in[29], p.in[30], (bf16_t*)(ws + WS_AB), side, side + SIDE_ELEMS, side + 2 * SIDE_ELEMS};
        pg8::gemm_phase<EpiUp, pg8::StaticOrder, true, true>(lds, g, S, E);
    }
    grid.sync();
    if constexpr ((PM >> 8) & 1) p8_fixup(p, tid);
    grid.sync();
    if constexpr ((PM >> 9) & 1) {
        pg8::Gemm g{(const bf16_t*)(ws + WS_AB), (const bf16_t*)(ws + WS_WDN), MT, 1024, DFF};
        pg8::StaticOrder S; S.init(MT, 1024, G, (int)blockIdx.x);
        EpiDown E{p.out};
        pg8::gemm_phase<EpiDown, pg8::StaticOrder, true, true>(lds, g, S, E);
    }
}

extern "C" void kernel_launch(void* const* d_in, const int* in_sizes, int n_in, void* d_out, int out_size, void* d_ws, size_t ws_size, hipStream_t stream) {
    static int grid = 0;
    if (grid == 0) {
        if (n_in != 32 || (size_t)out_size != OUT_TOTAL || ws_size < WS_END) { fprintf(stderr, "kernel_launch: unexpected shapes: n_in %d out %d ws %zu\n", n_in, out_size, ws_size); grid = -1; return; }
        int dev = 0, cus = 0, per_cu = 0;
        hipGetDevice(&dev); hipDeviceGetAttribute(&cus, hipDeviceAttributeMultiprocessorCount, dev);
        if (hipFuncSetAttribute((const void*)mega_fwd, hipFuncAttributeMaxDynamicSharedMemorySize, LDS_BYTES) != hipSuccess) { fprintf(stderr, "kernel_launch: hipFuncSetAttribute failed\n"); grid = -1; return; }
        if (hipOccupancyMaxActiveBlocksPerMultiprocessor(&per_cu, (const void*)mega_fwd, 512, LDS_BYTES) != hipSuccess || per_cu < 1) { fprintf(stderr, "kernel_launch: occupancy query says %d\n", per_cu); per_cu = 1; }
        (void)hipGetLastError();
        grid = cus;
    }
    if (grid < 0) return;
    Params p{};
    for (int i = 0; i < 32; ++i) p.in[i] = (const float*)d_in[i];
    p.out = (float*)d_out; p.ws = (unsigned char*)d_ws;
    void* args[] = {&p};
    hipError_t e = hipLaunchCooperativeKernel((const void*)mega_fwd, dim3(grid), dim3(512), args, LDS_BYTES, stream);
    if (e != hipSuccess) fprintf(stderr, "cooperative launch failed: %s (grid %d)\n", hipGetErrorString(e), grid);
}
```

```cpp
#include <hip/hip_runtime.h>
#include <hip/hip_cooperative_groups.h>
#include <cstdio>
#include <cstdint>
namespace cg = cooperative_groups;
namespace pg8 {
#define PG8_LAS __attribute__((address_space(3)))
typedef unsigned short bf16_t;
typedef short bf16x8 __attribute__((ext_vector_type(8)));
typedef float f32x4 __attribute__((ext_vector_type(4)));
typedef unsigned u32x4 __attribute__((ext_vector_type(4)));
constexpr int BM = 256, BK = 64, HALF = 128, HTB = HALF * BK * 2  , STAGE_BYTES = 8 * HTB, NXCD = 8, WGM = 8;

__host__ __device__ __forceinline__ int lds_byte(int r, int c) { const int st = (r >> 4) * 2 + (c >> 5), rr = r & 15, cc = c & 31, ob = rr * 64 + cc * 2; return st * 1024 + (ob ^ (((ob >> 9) & 1) << 5)); }
__host__ __device__ __forceinline__ void stage_rc(int b, int& R, int& C) { const int st = b / 1024, sb = b % 1024, swz = sb ^ (((sb >> 9) & 1) << 5); R = (st >> 1) * 16 + swz / 64; C = (st & 1) * 32 + (swz % 64) / 2; }
__host__ __device__ __forceinline__ int perm32(int rho) { const int n = rho >> 4, i = rho & 15; return 8 * (i >> 2) + 4 * n + (i & 3); }

struct Unit { int pm, pn; };
struct Gemm { const bf16_t* A; const bf16_t* Bt; int M, N, K; int nt; };

struct StaticOrder {
    int nM, nN, nwg, G, c;
    __host__ __device__ void init(int M, int N, int G_, int c_) { nM = M / BM; nN = N / BM; nwg = nM * nN; G = G_; c = c_; }
    __host__ __device__ bool next(int i, Unit& u) const {
        const long L = (long)i * G + c; if (L >= nwg) return false;
        int wgid = (int)L; { const int q = nwg / NXCD, r = nwg % NXCD, xcd = wgid % NXCD, off = wgid / NXCD; wgid = (xcd < r ? xcd * (q + 1) : r * (q + 1) + (xcd - r) * q) + off; }
        const int nig = WGM * nN, gid = wgid / nig, fm = gid * WGM, gsz = (nM - fm) < WGM ? (nM - fm) : WGM;
        u.pm = fm + ((wgid % nig) % gsz); u.pn = (wgid % nig) / gsz; return true;
    }
    __device__ __forceinline__ void a_ready(const Unit&) const {}
    __device__ __forceinline__ void done(const Unit&) const {}
};

typedef float f32x2 __attribute__((ext_vector_type(2)));
__device__ __forceinline__ unsigned cvt_pk_bf16(float lo, float hi) { unsigned r; asm volatile("v_cvt_pk_bf16_f32 %0, %1, %2" : "=v"(r) : "v"(lo), "v"(hi)); return r; }
template <class Epi, class Sched, bool ALIGN_EPI = false, bool SP2 = false>
__device__ __forceinline__ void gemm_phase(PG8_LAS unsigned char* lds, const Gemm g, const Sched& S, const Epi& E, const int tid_in) {
    int tid_ = tid_in; asm volatile("" : "+v"(tid_));
    const int tid = tid_, wid = __builtin_amdgcn_readfirstlane(tid >> 6), lane = tid & 63, wr = wid >> 2, wc = wid & 3, fr = lane & 15, fq = lane >> 4;
    const int K = g.K, nt = g.nt > 0 ? g.nt : K / BK;
    unsigned voffA[2], voffB[2];
#pragma unroll
    for (int i = 0; i < 2; ++i) { int R, C; stage_rc(tid * 16 + i * 8192, R, C); const int Rb = Epi::PERM ? ((R & ~31) + perm32(R & 31)) : R;
        voffA[i] = (unsigned)(R * K + C) * 2u; voffB[i] = (unsigned)(Rb * K + C) * 2u; }
    const size_t kstep = (size_t)(BK * 2);
    const size_t hstep = (size_t)HALF * K * 2;
    const size_t tstep = 2 * hstep;
    const unsigned ldsw = (unsigned)wid * 1024u;
    const int aoff = lds_byte(wr * 64 + fr, fq * 8), boff = lds_byte(wc * 32 + fr, fq * 8);
#define PG8_SA(b, h) (((b) * 2 + (h)) * HTB)
#define PG8_SB(b, h) ((4 + (b) * 2 + (h)) * HTB)
#define PG8_STAGE(bufoff, gbase, voff) do { _Pragma("unroll") for (int _i = 0; _i < 2; ++_i) \
        __builtin_amdgcn_global_load_lds((const unsigned*)((const char*)(gbase) + (voff)[_i]), (PG8_LAS unsigned*)(lds + (bufoff) + ldsw + _i * 8192), 16, 0, 0); } while (0)
#define PG8_LDA(dst, b, h) do { _Pragma("unroll") for (int m = 0; m < 4; ++m) _Pragma("unroll") for (int k = 0; k < 2; ++k) dst[m][k] = *(const PG8_LAS bf16x8*)(lds + PG8_SA(b, h) + aoff + m * 2048 + k * 1024); } while (0)
#define PG8_LDB(dst, b, h) do { _Pragma("unroll") for (int n = 0; n < 2; ++n) _Pragma("unroll") for (int k = 0; k < 2; ++k) dst[n][k] = *(const PG8_LAS bf16x8*)(lds + PG8_SB(b, h) + boff + n * 2048 + k * 1024); } while (0)
#define PG8_MMA(ai, bj, At, Bt) do { __builtin_amdgcn_s_setprio(1); _Pragma("unroll") for (int m = 0; m < 4; ++m) _Pragma("unroll") for (int n = 0; n < 2; ++n) _Pragma("unroll") for (int k = 0; k < 2; ++k) \
        acc[ai][bj][m][n] = __builtin_amdgcn_mfma_f32_16x16x32_bf16(Bt[n][k], At[m][k], acc[ai][bj][m][n], 0, 0, 0); __builtin_amdgcn_s_setprio(0); } while (0)
#define PG8_WAIT_V(n) asm volatile("s_waitcnt vmcnt(" #n ")" ::: "memory")
#define PG8_WAIT_L(n) asm volatile("s_waitcnt lgkmcnt(" #n ")" ::: "memory")
#define PG8_BAR __builtin_amdgcn_s_barrier()
#define PG8_SCHED __builtin_amdgcn_sched_barrier(0)
    Unit cur, nxt; int ui = 0;
    if (!S.next(0, cur)) return;
    f32x4 acc[2][2][4][2];
#pragma unroll
    for (int a = 0; a < 2; ++a)
#pragma unroll
        for (int b = 0; b < 2; ++b)
#pragma unroll
            for (int m = 0; m < 4; ++m)
#pragma unroll
                for (int n = 0; n < 2; ++n) acc[a][b][m][n] = (f32x4){0.f, 0.f, 0.f, 0.f};
    bf16x8 At[4][2], B0[2][2], B1[2][2];
    const char* cA = (const char*)g.A + (size_t)cur.pm * tstep; const char* cB = (const char*)g.Bt + (size_t)cur.pn * tstep;
    S.a_ready(cur);
    if constexpr (SP2) {
        PG8_STAGE(PG8_SB(0, 0), cB, voffB); PG8_STAGE(PG8_SB(0, 1), cB + hstep, voffB); PG8_STAGE(PG8_SA(0, 0), cA, voffA); PG8_STAGE(PG8_SA(0, 1), cA + hstep, voffA);
        if (wr == 1) PG8_BAR;
        PG8_WAIT_V(2); PG8_BAR;
        PG8_STAGE(PG8_SB(1, 0), cB + kstep, voffB); PG8_STAGE(PG8_SA(1, 0), cA + kstep, voffA); PG8_STAGE(PG8_SB(1, 1), cB + hstep + kstep, voffB);
        PG8_WAIT_V(6); PG8_BAR;
    } else {
        PG8_STAGE(PG8_SB(0, 0), cB, voffB); PG8_STAGE(PG8_SA(0, 0), cA, voffA); PG8_STAGE(PG8_SB(0, 1), cB + hstep, voffB); PG8_STAGE(PG8_SA(0, 1), cA + hstep, voffA);
        if (wr == 1) PG8_BAR;
        PG8_WAIT_V(4); PG8_BAR;
        PG8_STAGE(PG8_SB(1, 0), cB + kstep, voffB); PG8_STAGE(PG8_SA(1, 0), cA + kstep, voffA); PG8_STAGE(PG8_SB(1, 1), cB + hstep + kstep, voffB);
        PG8_WAIT_V(6); PG8_BAR;
    }
    for (;;) {
        const bool has_next = S.next(ui + 1, nxt);
        const char* nA = has_next ? (const char*)g.A + (size_t)nxt.pm * tstep : cA; const char* nB = has_next ? (const char*)g.Bt + (size_t)nxt.pn * tstep : cB;
        for (int t = 0; t < nt; t += 2) {
            const bool last = (t == nt - 2);
            const char* a1 = cA + (size_t)(t + 1) * kstep;
            const char* a2 = last ? nA : cA + (size_t)(t + 2) * kstep; const char* b2 = last ? nB : cB + (size_t)(t + 2) * kstep;
            const char* a3 = a2 + kstep; const char* b3 = b2 + kstep;
            if (last && has_next) S.a_ready(nxt);
            if constexpr (SP2) {
            PG8_LDB(B0, 0, 0); PG8_LDB(B1, 0, 1); PG8_SCHED; PG8_LDA(At, 0, 0); PG8_STAGE(PG8_SA(1, 1), a1 + hstep, voffA);
            PG8_WAIT_V(8); PG8_WAIT_L(0); PG8_BAR; PG8_MMA(0, 0, At, B0); PG8_MMA(0, 1, At, B1); PG8_BAR; PG8_SCHED;
            PG8_LDA(At, 0, 1); PG8_STAGE(PG8_SB(0, 0), b2, voffB); PG8_STAGE(PG8_SB(0, 1), b2 + hstep, voffB); PG8_STAGE(PG8_SA(0, 0), a2, voffA);
            PG8_WAIT_V(8); PG8_WAIT_L(0); PG8_BAR; PG8_MMA(1, 0, At, B0); PG8_MMA(1, 1, At, B1); PG8_BAR; PG8_SCHED;
            PG8_LDB(B0, 1, 0); PG8_LDB(B1, 1, 1); PG8_SCHED; PG8_LDA(At, 1, 0); PG8_STAGE(PG8_SA(0, 1), a2 + hstep, voffA);
            PG8_WAIT_V(8); PG8_WAIT_L(0); PG8_BAR; PG8_MMA(0, 0, At, B0); PG8_MMA(0, 1, At, B1); PG8_BAR; PG8_SCHED;
            PG8_LDA(At, 1, 1); PG8_STAGE(PG8_SB(1, 0), b3, voffB); PG8_STAGE(PG8_SB(1, 1), b3 + hstep, voffB); PG8_STAGE(PG8_SA(1, 0), a3, voffA);
            PG8_WAIT_V(8); PG8_WAIT_L(0); PG8_BAR; PG8_MMA(1, 0, At, B0); PG8_MMA(1, 1, At, B1); PG8_BAR; PG8_SCHED;
            } else {
            PG8_LDB(B0, 0, 0); PG8_SCHED; PG8_LDA(At, 0, 0); PG8_STAGE(PG8_SA(1, 1), a1 + hstep, voffA);
            PG8_WAIT_L(8); PG8_BAR; PG8_WAIT_L(0); PG8_MMA(0, 0, At, B0); PG8_BAR; PG8_SCHED;
            PG8_LDB(B1, 0, 1); PG8_STAGE(PG8_SB(0, 0), b2, voffB);
            PG8_BAR; PG8_WAIT_L(0); PG8_MMA(0, 1, At, B1); PG8_BAR;
            PG8_LDA(At, 0, 1); PG8_STAGE(PG8_SA(0, 0), a2, voffA);
            PG8_BAR; PG8_WAIT_L(0); PG8_MMA(1, 0, At, B0); PG8_BAR; PG8_SCHED;
            PG8_STAGE(PG8_SB(0, 1), b2 + hstep, voffB);
            PG8_WAIT_V(6); PG8_BAR; PG8_MMA(1, 1, At, B1); PG8_BAR;
            PG8_LDB(B0, 1, 0); PG8_SCHED; PG8_LDA(At, 1, 0); PG8_STAGE(PG8_SA(0, 1), a2 + hstep, voffA);
            PG8_WAIT_L(8); PG8_BAR; PG8_WAIT_L(0); PG8_MMA(0, 0, At, B0); PG8_BAR; PG8_SCHED;
            PG8_LDB(B1, 1, 1); PG8_STAGE(PG8_SB(1, 0), b3, voffB);
            PG8_BAR; PG8_WAIT_L(0); PG8_MMA(0, 1, At, B1); PG8_BAR;
            PG8_LDA(At, 1, 1); PG8_STAGE(PG8_SA(1, 0), a3, voffA);
            PG8_BAR; PG8_WAIT_L(0); PG8_MMA(1, 0, At, B0); PG8_BAR; PG8_SCHED;
            PG8_STAGE(PG8_SB(1, 1), b3 + hstep, voffB);
            PG8_WAIT_V(6); PG8_BAR; PG8_MMA(1, 1, At, B1); PG8_BAR;
            }
        }
        if constexpr (ALIGN_EPI) { if (wr == 0) PG8_BAR; }
        if constexpr (!Epi::AFTER_DRAIN) { E(acc, cur, wr, wc, fr, fq); S.done(cur); }
        if (!has_next) break;
#pragma unroll
        for (int a = 0; a < 2; ++a)
#pragma unroll
            for (int b = 0; b < 2; ++b)
#pragma unroll
                for (int m = 0; m < 4; ++m)
#pragma unroll
                    for (int n = 0; n < 2; ++n) acc[a][b][m][n] = (f32x4){0.f, 0.f, 0.f, 0.f};
        cur = nxt; cA = nA; cB = nB; ++ui;
        if constexpr (ALIGN_EPI) { if (wr == 1) PG8_BAR; }
    }
    PG8_WAIT_V(0);
    if constexpr (!ALIGN_EPI) { if (wr == 0) PG8_BAR; }
    PG8_BAR;
    if constexpr (Epi::AFTER_DRAIN) { E.fused(acc, cur, wr, wc, fr, fq, lds, wid, lane); S.done(cur); }
#undef PG8_SA
#undef PG8_SB
#undef PG8_STAGE
#undef PG8_LDA
#undef PG8_LDB
#undef PG8_MMA
#undef PG8_WAIT_V
#undef PG8_WAIT_L
#undef PG8_BAR
#undef PG8_SCHED
}
}

#define LAS __attribute__((address_space(3)))
using pg8::bf16_t; using pg8::bf16x8; using pg8::f32x4; using pg8::u32x4; using pg8::Unit;
typedef float f32x16 __attribute__((ext_vector_type(16)));
typedef short s16x4 __attribute__((ext_vector_type(4)));
typedef float f32x2v __attribute__((ext_vector_type(2)));
typedef __bf16 bf16x2v __attribute__((ext_vector_type(2)));
#define DI __device__ __forceinline__
#define LDS_WAIT() asm volatile("s_waitcnt lgkmcnt(0)" ::: "memory")

constexpr int DM = 1024, NP = 32768, NS = 1024, MT = NP + NS, MEMR = 2048, MA = MT + MEMR, DFF = 2816, NQKV = 3072;
constexpr float EPS = 1e-6f, LOG2E = 1.44269504088896f;
constexpr float QSCALE = 0.125f * LOG2E;
constexpr size_t OFF_Y = 0;
constexpr size_t OFF_AK_P = 34603008, OFF_AV_P = 36700160, OFF_BK_P = 38797312, OFF_BV_P = 55574528, OFF_BL_P = 72351744;
constexpr size_t OFF_MK_P = 72613888, OFF_MV_P = 74711040, OFF_CV_P = 76808192;
constexpr size_t OFF_AK_S = 76853248, OFF_AV_S = 77377536, OFF_BK_S = 77901824, OFF_BV_S = 78426112, OFF_BL_S = 78950400, OFF_CV_S = 78958592;
constexpr size_t OUT_TOTAL = 79048704;
constexpr size_t MiB = 1u << 20;
constexpr size_t WS_WIN = 0, WS_WO = 10 * MiB, WS_WMQ = 12 * MiB, WS_WMO = 14 * MiB, WS_WUP = 16 * MiB, WS_WDN = 28 * MiB;
constexpr size_t WS_RSTD1 = 34 * MiB, WS_SS2 = 34 * MiB + 256 * 1024, WS_SS3 = 34 * MiB + 512 * 1024, WS_CTR = 34 * MiB + 768 * 1024;
constexpr size_t WS_GTAB = 34 * MiB + 800 * 1024;
constexpr size_t WS_CUMP = 35 * MiB, WS_CUMS = 36 * MiB;
constexpr size_t WS_MK = 40 * MiB, WS_MV = 52 * MiB, WS_MEMRAW = 64 * MiB;
constexpr size_t WS_XB = 80 * MiB, WS_P = 150 * MiB, WS_O = 348 * MiB;
constexpr size_t WS_X1B = 80 * MiB, WS_QM = 146 * MiB, WS_OM = 212 * MiB, WS_X2B = 278 * MiB;
constexpr size_t WS_AB = 80 * MiB, WS_SIDE = 348 * MiB;
constexpr size_t SIDE_ELEMS = (size_t)528 * 2 * DFF;
constexpr size_t WS_END = 414 * MiB;
constexpr int LDS_BYTES = 143360 + 256;
constexpr int LDS_NEXT = 143360;

struct Params { const float* in[32]; float* out; unsigned char* ws; };

DI int fresh_tid(int wave_s) {
    int w = wave_s; unsigned m = ~0u; asm volatile("" : "+s"(w), "+s"(m));
    int t = w * 64 + (int)__builtin_amdgcn_mbcnt_hi(m, __builtin_amdgcn_mbcnt_lo(m, 0u)); asm volatile("" : "+v"(t)); return t; }
DI unsigned pk2(float lo, float hi) { f32x2v v = {lo, hi}; bf16x2v b = __builtin_convertvector(v, bf16x2v); return __builtin_bit_cast(unsigned, b); }
DI float bf2f(unsigned short s) { return __uint_as_float(((unsigned)s) << 16); }
DI float red_max32(float x) { auto r = __builtin_amdgcn_permlane32_swap(__float_as_uint(x), __float_as_uint(x), false, false); return fmaxf(__uint_as_float(r[0]), __uint_as_float(r[1])); }
DI float red_sum32(float x) { auto r = __builtin_amdgcn_permlane32_swap(__float_as_uint(x), __float_as_uint(x), false, false); return __uint_as_float(r[0]) + __uint_as_float(r[1]); }
DI float red_max16(float x) { auto r = __builtin_amdgcn_permlane16_swap(__float_as_uint(x), __float_as_uint(x), false, false); return fmaxf(__uint_as_float(r[0]), __uint_as_float(r[1])); }
DI float red_sum16(float x) { auto r = __builtin_amdgcn_permlane16_swap(__float_as_uint(x), __float_as_uint(x), false, false); return __uint_as_float(r[0]) + __uint_as_float(r[1]); }
template <int CTRL> DI float dpp_mov(float x) { return __uint_as_float((unsigned)__builtin_amdgcn_update_dpp(0, (int)__float_as_uint(x), CTRL, 0xf, 0xf, false)); }
DI float row16_sum(float v) { v += dpp_mov<0x128>(v); v += dpp_mov<0x124>(v); v += dpp_mov<0x122>(v); v += dpp_mov<0x121>(v); return v; }
DI float wave_sum(float v) { return red_sum32(red_sum16(row16_sum(v))); }
DI float wave_max(float v) { v = fmaxf(v, dpp_mov<0x128>(v)); v = fmaxf(v, dpp_mov<0x124>(v)); v = fmaxf(v, dpp_mov<0x122>(v)); v = fmaxf(v, dpp_mov<0x121>(v)); return red_max32(red_max16(v)); }
DI float lane_read(float x, int src_lane) { return __uint_as_float((unsigned)__builtin_amdgcn_ds_bpermute(src_lane << 2, (int)__float_as_uint(x))); }
DI u32x4 pack8(const f32x4& a, const f32x4& b) { u32x4 w; w.x = pk2(a[0], a[1]); w.y = pk2(a[2], a[3]); w.z = pk2(b[0], b[1]); w.w = pk2(b[2], b[3]); return w; }

DI void transpose_item(const float* W, int ldw, int K, const float* gk, bf16_t* WT, int destrow0, int k0, int n0, LAS float* scr, int lane) {
    float tv[32];
#pragma unroll
    for (int i = 0; i < 32; ++i) { const int kk = 2 * i + (lane >> 5); tv[i] = W[(size_t)(k0 + kk) * ldw + n0 + (lane & 31)]; }
#pragma unroll
    for (int i = 0; i < 32; ++i) { const int kk = 2 * i + (lane >> 5); float v = tv[i]; if (gk) v *= gk[k0 + kk]; scr[kk * 33 + (lane & 31)] = v; }
    LDS_WAIT(); asm volatile("" ::: "memory");
    const int c = lane & 7;
#pragma unroll
    for (int j = 0; j < 4; ++j) { const int n = (lane >> 3) + 8 * j; const LAS float* s = scr + (8 * c) * 33 + n;
        u32x4 o; o.x = pk2(s[0 * 33], s[1 * 33]); o.y = pk2(s[2 * 33], s[3 * 33]); o.z = pk2(s[4 * 33], s[5 * 33]); o.w = pk2(s[6 * 33], s[7 * 33]);
        *(u32x4*)(WT + (size_t)(destrow0 + n) * K + k0 + 8 * c) = o; }
    LDS_WAIT(); asm volatile("" ::: "memory");
}

DI void p0_prologue(const Params& p, LAS unsigned char* lds, int tid) {
    const int lane = tid & 63, wave = tid >> 6, G = gridDim.x;
    const int gw = blockIdx.x * 8 + wave, NGW = G * 8;
    const int gt = blockIdx.x * 512 + tid, NGT = G * 512;
    unsigned char* ws = p.ws;
    { float* ss2 = (float*)(ws + WS_SS2); float* ss3 = (float*)(ws + WS_SS3);
      for (int i = gt; i < MT; i += NGT) { ss2[i] = 0.f; ss3[i] = 0.f; }
      if (gt < 128) ((unsigned*)(ws + WS_CTR))[gt] = 0u;
      if (gt < 384) { const int ty = gt >> 6, d = gt & 63; ((float*)(ws + WS_GTAB))[gt] = ty == 0 ? p.in[13][d] : ty == 1 ? p.in[14][d] : ty == 3 ? p.in[16][d] : ty == 4 ? p.in[17][d] : 1.f; } }
    LAS float* wfl = (LAS float*)(lds + 73728);
    { const float* w_in = p.in[11]; const float* g1 = p.in[19];
      for (int e = tid; e < 8192; e += 512) { const int c = e >> 10, k = e & 1023; wfl[e] = w_in[(size_t)k * 3080 + 3072 + c] * g1[k]; } }
    __syncthreads();
    LAS float* scr = (LAS float*)(lds + wave * 8448);
    {
        constexpr int I_IN = 16 * 96, I_MKV = 16 * 64, I_SQ = 16 * 32, I_UP = 16 * 176, I_DN = 44 * 32;
        constexpr int NITEMS = I_IN + I_MKV + 3 * I_SQ + I_UP + I_DN;
        bf16_t* WTin = (bf16_t*)(ws + WS_WIN);
        for (int it = gw; it < NITEMS; it += NGW) {
            int r = it;
            if (r < I_IN) { const int kb = r / 96, nb = r % 96, n0 = 32 * nb;
                const int T = n0 >> 8, wc = (n0 >> 6) & 3, bj = (n0 >> 5) & 1;
                transpose_item(p.in[11], 3080, 1024, p.in[19], WTin, 256 * T + 128 * bj + 32 * wc, 64 * kb, n0, scr, lane); continue; } r -= I_IN;
            if (r < I_MKV) { const int kb = r / 64, nb = r % 64; transpose_item(p.in[23], 2048, 1024, p.in[21], WTin, 3072 + 32 * nb, 64 * kb, 32 * nb, scr, lane); continue; } r -= I_MKV;
            if (r < I_SQ) { const int kb = r / 32, nb = r % 32; transpose_item(p.in[18], 1024, 1024, nullptr, (bf16_t*)(ws + WS_WO), 32 * nb, 64 * kb, 32 * nb, scr, lane); continue; } r -= I_SQ;
            if (r < I_SQ) { const int kb = r / 32, nb = r % 32; transpose_item(p.in[22], 1024, 1024, p.in[20], (bf16_t*)(ws + WS_WMQ), 32 * nb, 64 * kb, 32 * nb, scr, lane); continue; } r -= I_SQ;
            if (r < I_SQ) { const int kb = r / 32, nb = r % 32; transpose_item(p.in[26], 1024, 1024, nullptr, (bf16_t*)(ws + WS_WMO), 32 * nb, 64 * kb, 32 * nb, scr, lane); continue; } r -= I_SQ;
            if (r < I_UP) { const int kb = r / 176, nb = r % 176, n0 = 32 * nb;
                const int dest = (n0 < DFF) ? 256 * (n0 >> 7) + (n0 & 127) : 256 * ((n0 - DFF) >> 7) + 128 + ((n0 - DFF) & 127);
                transpose_item(p.in[28], 2 * DFF, 1024, p.in[27], (bf16_t*)(ws + WS_WUP), dest, 64 * kb, n0, scr, lane); continue; } r -= I_UP;
            { const int kb = r / 32, nb = r % 32; transpose_item(p.in[31], 1024, DFF, nullptr, (bf16_t*)(ws + WS_WDN), 32 * nb, 64 * kb, 32 * nb, scr, lane); }
        }
    }
    {
        bf16_t* XB = (bf16_t*)(ws + WS_XB); float* rstd1 = (float*)(ws + WS_RSTD1);
        const float* bfv = p.in[12];
        const int l16 = lane & 15, grp = lane >> 4;
        for (int row4 = gw * 4; row4 < MA; row4 += NGW * 4) {
            const int row = row4 + grp;
            const float* src = row < NP ? p.in[0] + (size_t)row * DM : (row < MT ? p.in[1] + (size_t)(row - NP) * DM : p.in[10] + (size_t)(row - MT) * DM);
            f32x4 v[16]; float ss = 0.f;
#pragma unroll
            for (int j = 0; j < 16; ++j) v[j] = ((const f32x4*)src)[l16 + 16 * j];
#pragma unroll
            for (int j = 0; j < 16; ++j) ss += (v[j][0] * v[j][0] + v[j][1] * v[j][1]) + (v[j][2] * v[j][2] + v[j][3] * v[j][3]);
            ss = row16_sum(ss);
            const float rstd = rsqrtf(ss * (1.f / DM) + EPS);
            unsigned long long* o8 = (unsigned long long*)(XB + (size_t)row * DM) + l16;
#pragma unroll
            for (int j = 0; j < 16; ++j) o8[16 * j] = (unsigned long long)pk2(v[j][0], v[j][1]) | ((unsigned long long)pk2(v[j][2], v[j][3]) << 32);
            if (l16 == 0) rstd1[row] = rstd;
            if (row4 < MT) {
                float a[8];
#pragma unroll
                for (int c = 0; c < 8; ++c) {
                    float acc_ = 0.f; const LAS f32x4* wp = (const LAS f32x4*)wfl + 256 * c + l16;
#pragma unroll
                    for (int j = 0; j < 16; ++j) { const f32x4 w = wp[16 * j]; acc_ += (v[j][0] * w[0] + v[j][1] * w[1]) + (v[j][2] * w[2] + v[j][3] * w[3]); }
                    acc_ = row16_sum(acc_);
                    a[c] = acc_;
                }
                if (l16 < 8) {
                    const float av = l16 == 0 ? a[0] : l16 == 1 ? a[1] : l16 == 2 ? a[2] : l16 == 3 ? a[3] : l16 == 4 ? a[4] : l16 == 5 ? a[5] : l16 == 6 ? a[6] : a[7];
                    const float z = av * rstd + bfv[l16];
                    const float lf = fminf(z, 0.f) - log1pf(expf(-fabsf(z)));
                    float* dst = row < NP ? p.out + OFF_BL_P + (size_t)row * 8 : p.out + OFF_BL_S + (size_t)(row - NP) * 8;
                    dst[l16] = lf;
                }
            }
        }
    }
    {
        const f32x4* ck = (const f32x4*)p.in[7]; const f32x4* cv = (const f32x4*)p.in[8]; const f32x4* gq = (const f32x4*)p.in[24];
        unsigned long long* mk = (unsigned long long*)(ws + WS_MK) + (size_t)8 * 256 * 1024 / 4;
        unsigned long long* mv = (unsigned long long*)(ws + WS_MV) + (size_t)8 * 256 * 1024 / 4;
        for (int i0 = gt; i0 < 16 * 256 * 1024 / 4; i0 += 4 * NGT) {
            f32x4 kk_[4], vv_[4];
#pragma unroll
            for (int j = 0; j < 4; ++j) { const int i = i0 + j * NGT; if (i < 16 * 256 * 1024 / 4) { kk_[j] = ck[i]; vv_[j] = cv[i]; } }
#pragma unroll
            for (int j = 0; j < 4; ++j) { const int i = i0 + j * NGT; if (i >= 16 * 256 * 1024 / 4) break; const f32x4 g = gq[i & 63]; const f32x4 k = kk_[j] * g, v = vv_[j];
                mk[i] = (unsigned long long)pk2(k[0], k[1]) | ((unsigned long long)pk2(k[2], k[3]) << 32);
                mv[i] = (unsigned long long)pk2(v[0], v[1]) | ((unsigned long long)pk2(v[2], v[3]) << 32); }
        }
    }
    __syncthreads();
}

struct DualOrder {
    int n1, G, c, nM2, n2, pm_off, pn_off, nM, nN;
    DI bool next(int i, Unit& u) const {
        long L = (long)i * G + c;
        if (L < n1) {
            int wgid = (int)L; { const int q = n1 / 8, xcd = wgid % 8, off = wgid / 8; wgid = xcd * q + off; }
            const int nig = 8 * nN, gid = wgid / nig, fm = gid * 8, gsz = (nM - fm) < 8 ? (nM - fm) : 8;
            u.pm = fm + ((wgid % nig) % gsz); u.pn = (wgid % nig) / gsz; return true;
        }
        L -= n1; if (L >= n2) return false;
        u.pm = pm_off + (int)(L % nM2); u.pn = pn_off + (int)(L / nM2); return true;
    }
    DI void a_ready(const Unit&) const {}
    DI void done(const Unit&) const {}
};

struct EpiInProj {
    static constexpr bool PERM = true, AFTER_DRAIN = false;
    const float* rstd1; bf16_t* P; float* out; float* memraw; const float* gtab;
    DI void operator()(const f32x4 (&acc)[2][2][4][2], const Unit& u, int wr, int wc, int fr, int fq) const {
        if (u.pn >= 12) {
#pragma unroll
            for (int ai = 0; ai < 2; ++ai)
#pragma unroll
                for (int m = 0; m < 4; ++m) { const int row = u.pm * 256 + ai * 128 + wr * 64 + m * 16 + fr; const float rs = rstd1[row];
                    float* dst = memraw + (size_t)(row - MT) * 2048 + (u.pn - 12) * 256 + wc * 32 + 8 * fq;
#pragma unroll
                    for (int bj = 0; bj < 2; ++bj) { *(f32x4*)(dst + bj * 128) = acc[ai][bj][m][0] * rs; *(f32x4*)(dst + bj * 128 + 4) = acc[ai][bj][m][1] * rs; } }
            return;
        }
        const int type = u.pn >> 1, head = 4 * (u.pn & 1) + wc;
        const bool isq = (type == 0 || type == 3), isk = (type == 1 || type == 4);
        const float* g = gtab + type * 64;
        f32x4 gv[2][2];
#pragma unroll
        for (int bj = 0; bj < 2; ++bj)
#pragma unroll
            for (int n = 0; n < 2; ++n) gv[bj][n] = *(const f32x4*)(g + 32 * bj + 8 * fq + 4 * n);
#pragma unroll
        for (int ai = 0; ai < 2; ++ai)
#pragma unroll
            for (int m = 0; m < 4; ++m) {
                const int row = u.pm * 256 + ai * 128 + wr * 64 + m * 16 + fr; const float rs = rstd1[row];
                f32x4 v[2][2];
#pragma unroll
                for (int bj = 0; bj < 2; ++bj)
#pragma unroll
                    for (int n = 0; n < 2; ++n) v[bj][n] = acc[ai][bj][m][n] * rs;
                if (isq || isk) {
                    float ss = 0.f;
#pragma unroll
                    for (int bj = 0; bj < 2; ++bj)
#pragma unroll
                        for (int n = 0; n < 2; ++n) ss += (v[bj][n][0] * v[bj][n][0] + v[bj][n][1] * v[bj][n][1]) + (v[bj][n][2] * v[bj][n][2] + v[bj][n][3] * v[bj][n][3]);
                    ss = red_sum32(red_sum16(ss));
                    float r = rsqrtf(ss * (1.f / 64.f) + EPS); if (isq) r *= QSCALE;
#pragma unroll
                    for (int bj = 0; bj < 2; ++bj)
#pragma unroll
                        for (int n = 0; n < 2; ++n) v[bj][n] = v[bj][n] * r * gv[bj][n];
                }
                bf16_t* prow = P + (size_t)row * NQKV + type * 512 + head * 64 + 8 * fq;
#pragma unroll
                for (int bj = 0; bj < 2; ++bj) *(u32x4*)(prow + 32 * bj) = pack8(v[bj][0], v[bj][1]);
                if (!isq) {
                    float* dst = nullptr;
                    if (row < NP) { const int b = row >> 12, t = row & 4095;
                        if (type <= 2) { if (t >= 3584) dst = out + (type == 1 ? OFF_AK_P : OFF_AV_P) + ((size_t)(b * 512 + t - 3584) * 8 + head) * 64; }
                        else dst = out + (type == 4 ? OFF_BK_P : OFF_BV_P) + ((size_t)row * 8 + head) * 64; }
                    else { const int rs_ = row - NP;
                        dst = out + (type == 1 ? OFF_AK_S : type == 2 ? OFF_AV_S : type == 4 ? OFF_BK_S : OFF_BV_S) + ((size_t)rs_ * 8 + head) * 64; }
                    if (dst) {
#pragma unroll
                        for (int bj = 0; bj < 2; ++bj) { *(f32x4*)(dst + 32 * bj + 8 * fq) = v[bj][0]; *(f32x4*)(dst + 32 * bj + 8 * fq + 4) = v[bj][1]; } }
                }
            }
    }
};

DI void bf8_to_f32(const u32x4& w, f32x4& a, f32x4& b) {
    a[0] = __uint_as_float(w.x << 16); a[1] = __uint_as_float(w.x & 0xffff0000u); a[2] = __uint_as_float(w.y << 16); a[3] = __uint_as_float(w.y & 0xffff0000u);
    b[0] = __uint_as_float(w.z << 16); b[1] = __uint_as_float(w.z & 0xffff0000u); b[2] = __uint_as_float(w.w << 16); b[3] = __uint_as_float(w.w & 0xffff0000u);
}
template <bool SRC16>
struct EpiRes {
    static constexpr bool PERM = true, AFTER_DRAIN = false;
    const float* src_p; const float* src_s; const bf16_t* src16; bf16_t* XB; float* ss;
    DI void operator()(const f32x4 (&acc)[2][2][4][2], const Unit& u, int wr, int wc, int fr, int fq) const {
#pragma unroll
        for (int ai = 0; ai < 2; ++ai)
#pragma unroll
            for (int m = 0; m < 4; ++m) {
                const int row = u.pm * 256 + ai * 128 + wr * 64 + m * 16 + fr;
                const float* src = row < NP ? src_p + (size_t)row * DM : src_s + (size_t)(row - NP) * DM;
                float sq = 0.f;
#pragma unroll
                for (int bj = 0; bj < 2; ++bj) { const int col = u.pn * 256 + bj * 128 + wc * 32 + 8 * fq;
                    f32x4 r0, r1;
                    if (SRC16) bf8_to_f32(*(const u32x4*)(src16 + (size_t)row * DM + col), r0, r1);
                    else { r0 = *(const f32x4*)(src + col); r1 = *(const f32x4*)(src + col + 4); }
                    const f32x4 v0 = r0 + acc[ai][bj][m][0], v1 = r1 + acc[ai][bj][m][1];
                    *(u32x4*)(XB + (size_t)row * DM + col) = pack8(v0, v1);
                    sq += (v0[0] * v0[0] + v0[1] * v0[1]) + (v0[2] * v0[2] + v0[3] * v0[3]) + (v1[0] * v1[0] + v1[1] * v1[1]) + (v1[2] * v1[2] + v1[3] * v1[3]); }
                sq = red_sum32(red_sum16(sq));
                if (fq == 0) atomicAdd(ss + row, sq);
            }
    }
};
struct EpiScaleBf16 {
    static constexpr bool PERM = true, AFTER_DRAIN = false;
    const float* ss; bf16_t* O;
    DI void operator()(const f32x4 (&acc)[2][2][4][2], const Unit& u, int wr, int wc, int fr, int fq) const {
#pragma unroll
        for (int ai = 0; ai < 2; ++ai)
#pragma unroll
            for (int m = 0; m < 4; ++m) {
                const int row = u.pm * 256 + ai * 128 + wr * 64 + m * 16 + fr; const float rs = rsqrtf(ss[row] * (1.f / DM) + EPS);
#pragma unroll
                for (int bj = 0; bj < 2; ++bj) { const int col = u.pn * 256 + bj * 128 + wc * 32 + 8 * fq;
                    *(u32x4*)(O + (size_t)row * DM + col) = pack8(acc[ai][bj][m][0] * rs, acc[ai][bj][m][1] * rs); }
            }
    }
};
DI f32x4 silu_mul(const f32x4& c, const f32x4& v) { f32x4 r;
#pragma unroll
    for (int e = 0; e < 4; ++e) r[e] = c[e] / (1.f + __expf(-c[e])) * v[e];
    return r; }
struct EpiUp {
    static constexpr bool PERM = true, AFTER_DRAIN = false;
    const float* ss3; const float* wconv; const float* bconv; bf16_t* Ab; float* gfirst; float* vfirst; float* glast;
    DI void operator()(const f32x4 (&acc)[2][2][4][2], const Unit& u, int wr, int wc, int fr, int fq) const {
        const int col0 = u.pn * 128 + wc * 32 + 8 * fq, lane = fr + 16 * fq;
        const int s1 = (lane & ~15) | ((lane - 1) & 15), s2 = (lane & ~15) | ((lane - 2) & 15);
        f32x4 w0[2], w1[2], w2[2], bc[2];
#pragma unroll
        for (int n = 0; n < 2; ++n) { w0[n] = *(const f32x4*)(wconv + col0 + 4 * n); w1[n] = *(const f32x4*)(wconv + DFF + col0 + 4 * n); w2[n] = *(const f32x4*)(wconv + 2 * DFF + col0 + 4 * n); bc[n] = *(const f32x4*)(bconv + col0 + 4 * n); }
#pragma unroll
        for (int ai = 0; ai < 2; ++ai) {
            const int blk = u.pm * 4 + ai * 2 + wr;
            f32x4 pR1[2], pR2[2];
#pragma unroll
            for (int n = 0; n < 2; ++n) { pR1[n] = (f32x4){0.f, 0.f, 0.f, 0.f}; pR2[n] = pR1[n]; }
#pragma unroll
            for (int m = 0; m < 4; ++m) {
                const int row = u.pm * 256 + ai * 128 + wr * 64 + m * 16 + fr; const float rs = rsqrtf(ss3[row] * (1.f / DM) + EPS);
                f32x4 a[2];
#pragma unroll
                for (int n = 0; n < 2; ++n) {
                    const f32x4 g = acc[ai][0][m][n] * rs, vv = acc[ai][1][m][n] * rs; f32x4 R1, R2;
#pragma unroll
                    for (int e = 0; e < 4; ++e) { R1[e] = dpp_mov<0x121>(g[e]); R2[e] = dpp_mov<0x122>(g[e]); }
                    const f32x4 p1 = fr >= 1 ? R1 : pR1[n], p2 = fr >= 2 ? R2 : pR2[n];
                    const f32x4 cv = p2 * w0[n] + p1 * w1[n] + g * w2[n] + bc[n];
                    a[n] = silu_mul(cv, vv);
                    pR1[n] = R1; pR2[n] = R2;
                    if (m == 0 && fr < 2) { *(f32x4*)(gfirst + ((size_t)blk * 2 + fr) * DFF + col0 + 4 * n) = g; *(f32x4*)(vfirst + ((size_t)blk * 2 + fr) * DFF + col0 + 4 * n) = vv; }
                    if (m == 3 && fr >= 14) *(f32x4*)(glast + ((size_t)blk * 2 + fr - 14) * DFF + col0 + 4 * n) = g;
                }
                if (!(m == 0 && fr < 2)) *(u32x4*)(Ab + (size_t)row * DFF + col0) = pack8(a[0], a[1]);
            }
        }
    }
};
struct EpiPartial {
    static constexpr bool PERM = true, AFTER_DRAIN = false;
    float* part;
    DI void operator()(const f32x4 (&acc)[2][2][4][2], const Unit& u, int wr, int wc, int fr, int fq) const {
#pragma unroll
        for (int ai = 0; ai < 2; ++ai)
#pragma unroll
            for (int m = 0; m < 4; ++m) {
                float* o = part + (size_t)(ai * 128 + wr * 64 + m * 16 + fr) * 256 + wc * 32 + 8 * fq;
#pragma unroll
                for (int bj = 0; bj < 2; ++bj) { *(f32x4*)(o + bj * 128) = acc[ai][bj][m][0]; *(f32x4*)(o + bj * 128 + 4) = acc[ai][bj][m][1]; }
            }
    }
};
struct OneUnit {
    int pm, pn;
    DI bool next(int i, Unit& u) const { if (i > 0) return false; u.pm = pm; u.pn = pn; return true; }
    DI void a_ready(const Unit&) const {}
    DI void done(const Unit&) const {}
};
struct EpiDown {
    static constexpr bool PERM = true, AFTER_DRAIN = false;
    const bf16_t* X2B; float* out;
    DI void operator()(const f32x4 (&acc)[2][2][4][2], const Unit& u, int wr, int wc, int fr, int fq) const {
#pragma unroll
        for (int ai = 0; ai < 2; ++ai)
#pragma unroll
            for (int m = 0; m < 4; ++m) {
                const int row = u.pm * 256 + ai * 128 + wr * 64 + m * 16 + fr;
#pragma unroll
                for (int bj = 0; bj < 2; ++bj) { const size_t off = (size_t)row * DM + u.pn * 256 + bj * 128 + wc * 32 + 8 * fq;
                    f32x4 r0, r1; bf8_to_f32(*(const u32x4*)(X2B + off), r0, r1);
                    *(f32x4*)(out + off) = r0 + acc[ai][bj][m][0]; *(f32x4*)(out + off + 4) = r1 + acc[ai][bj][m][1]; }
                if (m & 1) __builtin_amdgcn_sched_barrier(0);
            }
    }
};

DI void cumsum_bh(const Params& p, LAS unsigned char* lds, int tid, int idx) {
    LAS float* wsum = (LAS float*)lds;
    const int beta = idx >> 3, h = idx & 7, lane = tid & 63, w = tid >> 6;
    const bool sample = beta >= 8; const int b = sample ? beta - 8 : beta;
    const int per = sample ? 9 : 8, T = sample ? 4160 : 4096;
    const float* lf_new = sample ? p.out + OFF_BL_S + (size_t)b * 64 * 8 : p.out + OFF_BL_P + (size_t)b * 4096 * 8;
    const float* lf_cache = p.in[6] + (size_t)b * 4096 * 8;
    float* dst = sample ? (float*)(p.ws + WS_CUMS) + ((size_t)b * 8 + h) * 4160 : (float*)(p.ws + WS_CUMP) + ((size_t)b * 8 + h) * 4096;
    float v[9];
#pragma unroll
    for (int i = 0; i < 9; ++i) { const int t = tid * per + i; float x = 0.f;
        if (i < per && t < T) x = sample ? (t < 4096 ? lf_cache[(size_t)t * 8 + h] : lf_new[(size_t)(t - 4096) * 8 + h]) : lf_new[(size_t)t * 8 + h];
        v[i] = x; }
    float s = 0.f;
#pragma unroll
    for (int i = 0; i < 9; ++i) { s += v[i]; v[i] = s; }
    float incl = s;
#pragma unroll
    for (int off = 1; off < 64; off <<= 1) { const float y = lane_read(incl, (lane - off) & 63); if (lane >= off) incl += y; }
    if (lane == 63) wsum[w] = incl;
    __syncthreads();
    float base = 0.f;
#pragma unroll
    for (int j = 0; j < 8; ++j) if (j < w) base += wsum[j];
    const float excl = base + incl - s;
#pragma unroll
    for (int i = 0; i < 9; ++i) { const int t = tid * per + i; if (i < per && t < T) dst[t] = excl + v[i]; }
    __syncthreads();
}

struct AttnArgs {
    const bf16_t* Q; int qstride; int nq; int qpos0; int kt_lo, kt_hi;
    const float* k32; const float* v32; int stride32; int n32;
    const bf16_t* k16; const bf16_t* v16; int stride16;
    bf16_t* O; int ostride;
    const float* cum; const float* tab; const float* gq; const float* gk;
};
DI f32x16 mfma32(bf16x8 a, bf16x8 b, f32x16 c) { return __builtin_amdgcn_mfma_f32_32x32x16_bf16(a, b, c, 0, 0, 0); }
typedef short v4i16_t __attribute__((ext_vector_type(4)));
DI s16x4 vtr(const LAS unsigned char* p) { return __builtin_bit_cast(s16x4, __builtin_amdgcn_ds_read_tr16_b64_v4i16((LAS v4i16_t*)p)); }

template <int D, int MODE, bool F32, int DV, int EXP = 0>
DI void attn_unit(LAS unsigned char* lds, const AttnArgs& a, int tid, int vcol0) {
    constexpr int KSTR = D * 2 + 16, TILE = 64 * KSTR, NCH = D / 8, PER = (64 * NCH) / 512;
    constexpr int VSTR = DV == 64 ? 192 : 288, VTILE = 64 * VSTR, NCHV = DV / 8, PERV = (64 * NCHV) / 512, BUFB = TILE + VTILE;
    constexpr int CUM_OFF = 2 * BUFB, TAB_OFF = CUM_OFF + 512;
    const int lane = tid & 63, w = __builtin_amdgcn_readfirstlane(tid >> 6), r = lane & 31, h = lane >> 5;
    const bool wact = 32 * w < a.nq;
    const int qrow = 32 * w + r, qpos = a.qpos0 + qrow, qw0 = a.qpos0 + 32 * w;
    int w_lo, w_hi;
    if (MODE == 0) { const int c = qw0 >> 6; w_lo = c - 8 < 0 ? 0 : c - 8; w_hi = c; }
    else if (MODE == 1) { w_lo = 0; w_hi = qw0 >> 6; }
    else { w_lo = a.kt_lo; w_hi = a.kt_hi; }
    if (!wact) { w_lo = 1; w_hi = 0; }
    bf16x8 qf[D / 16];
    {
        const bf16_t* qp = a.Q + (size_t)(wact ? qrow : 0) * a.qstride + 8 * h;
#pragma unroll
        for (int kk = 0; kk < D / 16; ++kk) qf[kk] = *(const bf16x8*)(qp + 16 * kk);
    }
    float sc = 1.f;
    if (MODE == 2) {
        float ss = 0.f;
#pragma unroll
        for (int kk = 0; kk < D / 16; ++kk)
#pragma unroll
            for (int j = 0; j < 8; ++j) { const float f = bf2f((unsigned short)qf[kk][j]); ss += f * f; }
        ss = red_sum32(ss);
        sc = rsqrtf(ss * (1.f / 256.f) + EPS) * 0.0625f * LOG2E;
    }
    float cref = 0.f;
    if (MODE == 1) cref = a.cum[a.qpos0];
    float sinit = 0.f;
    if (MODE != 2) {
        float gm = wave_max(fabsf(a.gq[lane])) * wave_max(fabsf(a.gk[lane])) * 8.f * LOG2E;
        if (MODE == 0) { float tm = fabsf(a.tab[lane]); tm = fmaxf(tm, fabsf(a.tab[lane + 64])); tm = fmaxf(tm, fabsf(a.tab[lane + 128])); tm = fmaxf(tm, fabsf(a.tab[lane + 192])); tm = fmaxf(tm, fabsf(a.tab[256])); gm += wave_max(tm) * LOG2E; }
        sinit = -gm;
        if (MODE == 1) sinit += (a.cum[wact ? qpos : a.qpos0] - cref) * LOG2E;
    }
    LAS float* tabl = (LAS float*)(lds + TAB_OFF);
    if (MODE == 0) { if (tid < 257) { const int rel = 192 - tid; tabl[tid] = a.tab[(rel > 128 ? 128 : rel) + 128] * LOG2E; } }
    f32x16 o[DV / 32];
#pragma unroll
    for (int n = 0; n < DV / 32; ++n)
#pragma unroll
        for (int i = 0; i < 16; ++i) o[n][i] = 0.f;
    float mrun = -1e30f, lrun = 0.f;

    u32x4 kr[2][PER], vr[2][PERV]; f32x4 kr2[2], vr2[2], kr3[2], vr3[2]; bool was32[2] = {false, false}; float cumr[2] = {0.f, 0.f};
#pragma unroll
    for (int i_ = 0; i_ < 2; ++i_) { kr2[i_] = (f32x4){0.f, 0.f, 0.f, 0.f}; vr2[i_] = kr2[i_]; kr3[i_] = kr2[i_]; vr3[i_] = kr2[i_]; }
    constexpr int RPK = 512 / NCH, RPV = 512 / NCHV;
    const unsigned voffK = (unsigned)((tid / NCH) * a.stride16 + 8 * (tid % NCH)) * 2u, voffV = (unsigned)((tid / NCHV) * a.stride16 + 8 * (tid % NCHV)) * 2u;
    const unsigned voff32 = (unsigned)((tid >> 3) * a.stride32 + 8 * (tid & 7)) * 4u;
    const unsigned ldsK = (unsigned)((tid / NCH) * KSTR + 16 * (tid % NCH)), ldsV = (unsigned)(TILE + (tid / NCHV) * VSTR + 16 * (tid % NCHV));
#define ISSUE(S, KT) do { const int kt_ = (KT); \
        if (F32 && kt_ < a.n32) { was32[S] = true; \
            const char* kb32_ = (const char*)a.k32 + (size_t)(64 * kt_) * a.stride32 * 4; const char* vb32_ = (const char*)a.v32 + (size_t)(64 * kt_) * a.stride32 * 4; \
            kr3[S] = *(const f32x4*)(kb32_ + voff32); kr2[S] = *(const f32x4*)(kb32_ + voff32 + 16); vr3[S] = *(const f32x4*)(vb32_ + voff32); vr2[S] = *(const f32x4*)(vb32_ + voff32 + 16); } \
        else { was32[S] = false; \
            const char* kb16_ = (const char*)a.k16 + (size_t)(64 * (kt_ - a.n32)) * a.stride16 * 2; const char* vb16_ = (const char*)(a.v16 + vcol0) + (size_t)(64 * (kt_ - a.n32)) * a.stride16 * 2; \
            _Pragma("unroll") for (int j_ = 0; j_ < PER; ++j_) kr[S][j_] = *(const u32x4*)(kb16_ + (size_t)(j_ * RPK) * a.stride16 * 2 + voffK); \
            _Pragma("unroll") for (int j_ = 0; j_ < PERV; ++j_) vr[S][j_] = *(const u32x4*)(vb16_ + (size_t)(j_ * RPV) * a.stride16 * 2 + voffV); } \
        if (MODE == 1 && tid < 64) cumr[S] = a.cum[64 * kt_ + tid]; } while (0)
#define WRITE(S, BUF) do { LAS unsigned char* kb_ = lds + (BUF) * BUFB; \
        if (F32 && was32[S]) { *(LAS u32x4*)(kb_ + ldsK) = pack8(kr3[S], kr2[S]); *(LAS u32x4*)(kb_ + ldsV) = pack8(vr3[S], vr2[S]); } \
        else { _Pragma("unroll") for (int j_ = 0; j_ < PER; ++j_) *(LAS u32x4*)(kb_ + ldsK + j_ * RPK * KSTR) = kr[S][j_]; \
            _Pragma("unroll") for (int j_ = 0; j_ < PERV; ++j_) *(LAS u32x4*)(kb_ + ldsV + j_ * RPV * VSTR) = vr[S][j_]; } \
        if (MODE == 1 && tid < 64) ((LAS float*)(lds + CUM_OFF))[(BUF) * 64 + tid] = (cumr[S] - cref) * LOG2E; } while (0)

    const int rs23 = (r & ~12) | ((r & 4) << 1) | ((r & 8) >> 1);
    const int i16 = lane & 15, q_ = i16 >> 2, p_ = i16 & 3, g_ = (lane >> 4) & 1;
    constexpr int DIR = (MODE == 1) ? -1 : 1;
    const int kt_first = DIR > 0 ? a.kt_lo : a.kt_hi, ntiles = a.kt_hi - a.kt_lo + 1;
    ISSUE(0, kt_first); if (ntiles > 1) ISSUE(1, kt_first + DIR);
    WRITE(0, 0); __syncthreads();
    for (int it0 = 0; it0 < ntiles; it0 += 2) {
#pragma unroll
      for (int half = 0; half < 2; ++half) {
        const int it = it0 + half; if (it >= ntiles) break;
        const int kt = kt_first + DIR * it;
        const int buf = half;
        if (it + 2 < ntiles) ISSUE(half, kt + 2 * DIR);
        if (EXP != 4 && kt >= w_lo && kt <= w_hi) {
            const LAS unsigned char* Kt = lds + buf * BUFB; const LAS unsigned char* Vt = Kt + TILE;
            const LAS float* cl = (const LAS float*)(lds + CUM_OFF) + buf * 64;
#pragma unroll
            for (int stp = 0; stp < 2; ++stp) {
                const int step = DIR > 0 ? stp : 1 - stp;
                const int kpos0 = 64 * kt + 32 * step;
                if (MODE == 1 && kpos0 > qw0) continue;
                f32x16 s;
                const bool farb = (MODE == 0) && (qw0 - (kpos0 + 31) >= 128);
                const float s0v = farb ? sinit + tabl[0] : sinit;
#pragma unroll
                for (int i = 0; i < 16; ++i) s[i] = (MODE == 2) ? 0.f : s0v;
                const LAS unsigned char* kp = Kt + (32 * step + rs23) * KSTR + 16 * h;
                const LAS unsigned char* vb = Vt + (32 * step + 8 * h + q_) * VSTR + 32 * g_ + 8 * p_;
                bf16x8 kf[D / 16]; s16x4 vlo[DV / 32][2], vhi[DV / 32][2];
#pragma unroll
                for (int kk = 0; kk < D / 16; ++kk) kf[kk] = *(const LAS bf16x8*)(kp + 32 * kk);
#pragma unroll
                for (int n = 0; n < DV / 32; ++n) { vlo[n][0] = vtr(vb + 64 * n); vhi[n][0] = vtr(vb + 4 * VSTR + 64 * n); vlo[n][1] = vtr(vb + 16 * VSTR + 64 * n); vhi[n][1] = vtr(vb + 20 * VSTR + 64 * n); }
                __builtin_amdgcn_sched_barrier(0);
#pragma unroll
                for (int kk = 0; kk < D / 16; ++kk) { if (EXP == 3) { s[kk] += bf2f((unsigned short)kf[kk][0]) + bf2f((unsigned short)kf[kk][3]); } else s = mfma32(kf[kk], qf[kk], s); }
                if (MODE == 0) {
                    if (!farb) {
                        { const LAS float* tb = tabl + (192 - qpos + kpos0 + 8 * h);
#pragma unroll
                        for (int i = 0; i < 16; ++i) s[i] += tb[16 * (i >> 3) + (i & 7)]; } }
                } else if (MODE == 1) {
                    const LAS f32x4* c4 = (const LAS f32x4*)(cl + 32 * step + 8 * h);
                    const f32x4 c0 = c4[0], c1 = c4[1], c2 = c4[4], c3 = c4[5];
#pragma unroll
                    for (int e = 0; e < 4; ++e) { s[e] -= c0[e]; s[4 + e] -= c1[e]; s[8 + e] -= c2[e]; s[12 + e] -= c3[e]; }
                    if (kpos0 == qw0) {
#pragma unroll
                        for (int i = 0; i < 16; ++i) if (16 * (i >> 3) + 8 * h + (i & 7) > r) s[i] = -1e30f; }
                } else {
#pragma unroll
                    for (int i = 0; i < 16; ++i) s[i] *= sc;
                }
                if (MODE == 2) {
                float mx = s[0];
#pragma unroll
                for (int i = 1; i < 16; ++i) mx = fmaxf(mx, s[i]);
                mx = red_max32(mx);
                if (__builtin_amdgcn_ballot_w64(mx > mrun) != 0ull) {
                    const float mnew = fmaxf(mrun, mx), alpha = __builtin_amdgcn_exp2f(mrun - mnew); mrun = mnew; lrun *= alpha;
#pragma unroll
                    for (int n = 0; n < DV / 32; ++n)
#pragma unroll
                        for (int i = 0; i < 16; ++i) o[n][i] *= alpha;
                }
                float psum = 0.f;
#pragma unroll
                for (int i = 0; i < 16; ++i) { s[i] = __builtin_amdgcn_exp2f(s[i] - mrun); psum += s[i]; }
                lrun += psum;
                } else {
                float psum = 0.f;
#pragma unroll
                for (int i = 0; i < 16; ++i) { s[i] = __builtin_amdgcn_exp2f(s[i]); psum += s[i]; }
                lrun += psum;
                }
                u32x4 pw0, pw1;
                pw0.x = pk2(s[0], s[1]); pw0.y = pk2(s[2], s[3]); pw0.z = pk2(s[4], s[5]); pw0.w = pk2(s[6], s[7]);
                pw1.x = pk2(s[8], s[9]); pw1.y = pk2(s[10], s[11]); pw1.z = pk2(s[12], s[13]); pw1.w = pk2(s[14], s[15]);
                const bf16x8 pf0 = __builtin_bit_cast(bf16x8, pw0), pf1 = __builtin_bit_cast(bf16x8, pw1);
#pragma unroll
                for (int n = 0; n < DV / 32; ++n) {
                    { const bf16x8 vf = __builtin_shufflevector(vlo[n][0], vhi[n][0], 0, 1, 2, 3, 4, 5, 6, 7); if (EXP == 3) o[n][0] += bf2f((unsigned short)vf[0]) * bf2f((unsigned short)pf0[n]); else o[n] = mfma32(vf, pf0, o[n]); }
                    { const bf16x8 vf = __builtin_shufflevector(vlo[n][1], vhi[n][1], 0, 1, 2, 3, 4, 5, 6, 7); if (EXP == 3) o[n][1] += bf2f((unsigned short)vf[1]) * bf2f((unsigned short)pf1[n]); else o[n] = mfma32(vf, pf1, o[n]); }
                }
            }
        }
        if (it + 1 < ntiles) WRITE(half ^ 1, buf ^ 1);
        __syncthreads();
      }
    }
#undef ISSUE
#undef WRITE
    if (wact) {
        const float lt = red_sum32(lrun), inv = 1.f / lt;
        bf16_t* op = a.O + vcol0 + (size_t)qrow * a.ostride + 4 * h;
#pragma unroll
        for (int n = 0; n < DV / 32; ++n)
#pragma unroll
            for (int i4 = 0; i4 < 4; ++i4) {
                const unsigned lo = pk2(o[n][4 * i4] * inv, o[n][4 * i4 + 1] * inv), hi = pk2(o[n][4 * i4 + 2] * inv, o[n][4 * i4 + 3] * inv);
                *(unsigned long long*)(op + 32 * n + 8 * i4) = (unsigned long long)lo | ((unsigned long long)hi << 32);
            }
    }
}

DI void memnorm_rows(const Params& p, int item, int tid) {
    const int lane = tid & 63, wave = tid >> 6;
    const float* raw = (const float*)(p.ws + WS_MEMRAW);
    bf16_t* MK = (bf16_t*)(p.ws + WS_MK); bf16_t* MV = (bf16_t*)(p.ws + WS_MV);
    const f32x4 gk = ((const f32x4*)p.in[25])[lane], gq = ((const f32x4*)p.in[24])[lane];
    for (int i = 0; i < 4; ++i) {
        const int row = item * 32 + wave * 4 + i; const float* rr = raw + (size_t)row * 2048;
#pragma unroll
        for (int hm = 0; hm < 4; ++hm) {
            f32x4 v = ((const f32x4*)(rr + hm * 256))[lane];
            float ss = (v[0] * v[0] + v[1] * v[1]) + (v[2] * v[2] + v[3] * v[3]); ss = wave_sum(ss);
            const float rs = rsqrtf(ss * (1.f / 256.f) + EPS);
            v = v * rs * gk;
            ((f32x4*)(p.out + OFF_MK_P + (size_t)row * 1024 + hm * 256))[lane] = v;
            const f32x4 vq = v * gq;
            ((unsigned long long*)(MK + (size_t)row * 1024 + hm * 256))[lane] = (unsigned long long)pk2(vq[0], vq[1]) | ((unsigned long long)pk2(vq[2], vq[3]) << 32);
            const f32x4 vv = ((const f32x4*)(rr + 1024 + hm * 256))[lane];
            ((f32x4*)(p.out + OFF_MV_P + (size_t)row * 1024 + hm * 256))[lane] = vv;
            ((unsigned long long*)(MV + (size_t)row * 1024 + hm * 256))[lane] = (unsigned long long)pk2(vv[0], vv[1]) | ((unsigned long long)pk2(vv[2], vv[3]) << 32);
        }
    }
}

DI void gbar(unsigned* ctr, unsigned target, int tid) {
    asm volatile("s_waitcnt vmcnt(0)" ::: "memory");
    __syncthreads();
    if (tid == 0) {
        __builtin_amdgcn_fence(__ATOMIC_RELEASE, "agent");
        asm volatile("s_waitcnt vmcnt(0)" ::: "memory");
        __hip_atomic_fetch_add(ctr, 1u, __ATOMIC_RELAXED, __HIP_MEMORY_SCOPE_AGENT);
        while (__hip_atomic_load(ctr, __ATOMIC_RELAXED, __HIP_MEMORY_SCOPE_AGENT) < target) __builtin_amdgcn_s_sleep(1);
        __builtin_amdgcn_fence(__ATOMIC_ACQUIRE, "agent");
        asm volatile("s_waitcnt vmcnt(0)" ::: "memory");
    }
    __syncthreads();
}

DI int next_unit(LAS unsigned char* lds, unsigned* ctr, int tid) {
    LAS unsigned* nw = (LAS unsigned*)(lds + LDS_NEXT);
    if (tid == 0) *nw = atomicAdd(ctr, 1u);
    __syncthreads();
    const int u = (int)*nw;
    __syncthreads();
    return u;
}

template <int EXP>
DI void p2_attention(const Params& p, LAS unsigned char* lds, int tid) {
    unsigned* ctr = (unsigned*)(p.ws + WS_CTR) + (EXP ? 8 : 0);
    const bf16_t* P = (const bf16_t*)(p.ws + WS_P); bf16_t* Ob = (bf16_t*)(p.ws + (EXP ? WS_XB : WS_O));
    for (;;) {
        const int u = next_unit(lds, ctr, tid);
        if (u >= 2368) break;
        AttnArgs a; a.qstride = NQKV; a.stride16 = NQKV; a.ostride = DM; a.stride32 = 512; a.n32 = 0; a.k32 = nullptr; a.v32 = nullptr; a.cum = nullptr; a.tab = nullptr; a.gq = nullptr; a.gk = nullptr;
        if (u < 128) { const int b = u >> 3, h = u & 7; const size_t r0 = (size_t)(NP + 64 * b);
            a.Q = P + r0 * NQKV + 1536 + 64 * h; a.nq = 64; a.qpos0 = 4096; a.kt_lo = 0; a.kt_hi = 64; a.n32 = 64;
            a.k32 = p.in[4] + (size_t)b * 4096 * 512 + 64 * h; a.v32 = p.in[5] + (size_t)b * 4096 * 512 + 64 * h;
            a.k16 = P + r0 * NQKV + 2048 + 64 * h; a.v16 = P + r0 * NQKV + 2560 + 64 * h; a.O = Ob + r0 * DM + 512 + 64 * h;
            a.cum = (const float*)(p.ws + WS_CUMS) + ((size_t)b * 8 + h) * 4160; a.gq = p.in[16]; a.gk = p.in[17];
            attn_unit<64, 1, true, 64, EXP>(lds, a, tid, 0);
        } else if (u < 1152) { const int v = u - 128, g = 15 - (v >> 6), b = (v & 63) >> 3, h = v & 7; const size_t r0 = (size_t)b * 4096;
            a.Q = P + (r0 + 256 * g) * NQKV + 1536 + 64 * h; a.nq = 256; a.qpos0 = 256 * g; a.kt_lo = 0; a.kt_hi = 4 * g + 3;
            a.k16 = P + r0 * NQKV + 2048 + 64 * h; a.v16 = P + r0 * NQKV + 2560 + 64 * h; a.O = Ob + (r0 + 256 * g) * DM + 512 + 64 * h;
            a.cum = (const float*)(p.ws + WS_CUMP) + ((size_t)b * 8 + h) * 4096; a.gq = p.in[16]; a.gk = p.in[17];
            attn_unit<64, 1, false, 64, EXP>(lds, a, tid, 0);
        } else if (u < 2176) { const int v = u - 1152, g = v >> 6, b = (v & 63) >> 3, h = v & 7; const size_t r0 = (size_t)b * 4096;
            a.Q = P + (r0 + 256 * g) * NQKV + 64 * h; a.nq = 256; a.qpos0 = 256 * g; a.kt_lo = 4 * g - 8 < 0 ? 0 : 4 * g - 8; a.kt_hi = 4 * g + 3;
            a.k16 = P + r0 * NQKV + 512 + 64 * h; a.v16 = P + r0 * NQKV + 1024 + 64 * h; a.O = Ob + (r0 + 256 * g) * DM + 64 * h;
            a.tab = p.in[15] + h * 257; a.gq = p.in[13]; a.gk = p.in[14];
            attn_unit<64, 0, false, 64, EXP>(lds, a, tid, 0);
        } else if (u < 2304) { const int v = u - 2176, b = v >> 3, h = v & 7; const size_t r0 = (size_t)(NP + 64 * b);
            a.Q = P + r0 * NQKV + 64 * h; a.nq = 64; a.qpos0 = 512; a.kt_lo = 0; a.kt_hi = 8; a.n32 = 8;
            a.k32 = p.in[2] + (size_t)b * 512 * 512 + 64 * h; a.v32 = p.in[3] + (size_t)b * 512 * 512 + 64 * h;
            a.k16 = P + r0 * NQKV + 512 + 64 * h; a.v16 = P + r0 * NQKV + 1024 + 64 * h; a.O = Ob + r0 * DM + 64 * h;
            a.tab = p.in[15] + h * 257; a.gq = p.in[13]; a.gk = p.in[14];
            attn_unit<64, 0, true, 64, EXP>(lds, a, tid, 0);
        } else {
            if (!EXP) memnorm_rows(p, u - 2304, tid);
        }
    }
}

DI f32x4 mfma16(bf16x8 a, bf16x8 b, f32x4 c) { return __builtin_amdgcn_mfma_f32_16x16x32_bf16(a, b, c, 0, 0, 0); }
DI void mem_attn_unit(LAS unsigned char* lds, const bf16_t* Q, const bf16_t* K, const bf16_t* V, bf16_t* O, int nq, int tid) {
    constexpr int KSTR = 560, TILE = 64 * KSTR, BUFB = 2 * TILE;
    const int lane = tid & 63, w = __builtin_amdgcn_readfirstlane(tid >> 6), col = lane & 15, quad = lane >> 4;
    const bool wact = 16 * w < nq;
    const int qrow = 16 * w + col;
    f32x4 o[16];
#pragma unroll
    for (int mb = 0; mb < 16; ++mb) o[mb] = (f32x4){0.f, 0.f, 0.f, 0.f};
    float mrun = -1e30f, lrun = 0.f;
    u32x4 kr[4], vr[4];
    const unsigned voff = (unsigned)((tid >> 5) * DM + 8 * (tid & 31)) * 2u, ldso = (unsigned)((tid >> 5) * KSTR + 16 * (tid & 31));
#define MISSUE(KT) do { const char* kb_ = (const char*)K + (size_t)(64 * (KT)) * DM * 2; const char* vb_ = (const char*)V + (size_t)(64 * (KT)) * DM * 2; \
        _Pragma("unroll") for (int j_ = 0; j_ < 4; ++j_) { kr[j_] = *(const u32x4*)(kb_ + (size_t)(16 * j_) * DM * 2 + voff); vr[j_] = *(const u32x4*)(vb_ + (size_t)(16 * j_) * DM * 2 + voff); } } while (0)
#define MWRITE(BUF) do { LAS unsigned char* b_ = lds + (BUF) * BUFB + ldso; \
        _Pragma("unroll") for (int j_ = 0; j_ < 4; ++j_) { *(LAS u32x4*)(b_ + 16 * j_ * KSTR) = kr[j_]; *(LAS u32x4*)(b_ + TILE + 16 * j_ * KSTR) = vr[j_]; } } while (0)
    const int q_ = col >> 2, p_ = col & 3;
    MISSUE(0);
    bf16x8 qf[8];
    { const bf16_t* qp = Q + (size_t)(wact ? qrow : 0) * DM + 8 * quad;
#pragma unroll
      for (int kk = 0; kk < 8; ++kk) qf[kk] = *(const bf16x8*)(qp + 32 * kk); }
    float ss = 0.f;
#pragma unroll
    for (int kk = 0; kk < 8; ++kk)
#pragma unroll
        for (int j = 0; j < 8; ++j) { const float f = bf2f((unsigned short)qf[kk][j]); ss += f * f; }
    ss = red_sum32(red_sum16(ss));
    const float sc = rsqrtf(ss * (1.f / 256.f) + EPS) * 0.0625f * LOG2E;
    MWRITE(0); __syncthreads();
#pragma unroll 1
    for (int kt = 0; kt < 4; ++kt) {
        const int buf = kt & 1; const bool more = kt < 3;
        if (more) MISSUE(kt + 1);
        if (wact) {
            const LAS unsigned char* Kt = lds + buf * BUFB; const LAS unsigned char* Vt = Kt + TILE;
#pragma unroll
            for (int step = 0; step < 2; ++step) {
                f32x4 s0 = {0.f, 0.f, 0.f, 0.f}, s1 = s0;
                const LAS unsigned char* kp = Kt + (32 * step + col) * KSTR + 16 * quad;
#pragma unroll
                for (int kk = 0; kk < 8; ++kk) { const bf16x8 k0 = *(const LAS bf16x8*)(kp + 64 * kk), k1 = *(const LAS bf16x8*)(kp + 16 * KSTR + 64 * kk);
                    s0 = mfma16(k0, qf[kk], s0); s1 = mfma16(k1, qf[kk], s1); }
                s0 = s0 * sc; s1 = s1 * sc;
                float mx = fmaxf(fmaxf(fmaxf(s0[0], s0[1]), fmaxf(s0[2], s0[3])), fmaxf(fmaxf(s1[0], s1[1]), fmaxf(s1[2], s1[3])));
                mx = red_max32(red_max16(mx));
                const float mnew = fmaxf(mrun, mx), alpha = __builtin_amdgcn_exp2f(mrun - mnew); mrun = mnew;
                float psum = 0.f;
#pragma unroll
                for (int i = 0; i < 4; ++i) { s0[i] = __builtin_amdgcn_exp2f(s0[i] - mnew); s1[i] = __builtin_amdgcn_exp2f(s1[i] - mnew); psum += s0[i] + s1[i]; }
                lrun = lrun * alpha + psum;
#pragma unroll
                for (int mb = 0; mb < 16; ++mb) o[mb] = o[mb] * alpha;
                u32x4 pw; pw.x = pk2(s0[0], s0[1]); pw.y = pk2(s0[2], s0[3]); pw.z = pk2(s1[0], s1[1]); pw.w = pk2(s1[2], s1[3]);
                const bf16x8 pf = __builtin_bit_cast(bf16x8, pw);
                const LAS unsigned char* vb = Vt + (32 * step + 4 * quad + q_) * KSTR + 8 * p_;
#pragma unroll
                for (int mb = 0; mb < 16; ++mb) { const s16x4 lo = vtr(vb + 32 * mb), hi = vtr(vb + 16 * KSTR + 32 * mb);
                    const bf16x8 vf = __builtin_shufflevector(lo, hi, 0, 1, 2, 3, 4, 5, 6, 7); o[mb] = mfma16(vf, pf, o[mb]); }
            }
        }
        if (more) MWRITE(buf ^ 1);
        __syncthreads();
    }
#undef MISSUE
#undef MWRITE
    if (wact) {
        const float lt = red_sum32(red_sum16(lrun));
        const float inv = 1.f / lt;
        bf16_t* op = O + (size_t)qrow * DM + 4 * quad;
#pragma unroll
        for (int mb = 0; mb < 16; ++mb)
            *(unsigned long long*)(op + 16 * mb) = (unsigned long long)pk2(o[mb][0] * inv, o[mb][1] * inv) | ((unsigned long long)pk2(o[mb][2] * inv, o[mb][3] * inv) << 32);
    }
}

DI void p5_mem_attention(const Params& p, LAS unsigned char* lds, int tid) {
    const bf16_t* QM = (const bf16_t*)(p.ws + WS_QM); bf16_t* OM = (bf16_t*)(p.ws + WS_OM);
    const bf16_t* MK = (const bf16_t*)(p.ws + WS_MK); const bf16_t* MV = (const bf16_t*)(p.ws + WS_MV);
    for (int u = (int)blockIdx.x; u < 1088; u += (int)gridDim.x) {
        size_t r0; int kvb, hm, nq;
        if (u < 1024) { const int g = u & 31, b = u >> 7; hm = (u >> 5) & 3; r0 = (size_t)b * 4096 + 128 * g; kvb = b; nq = 128; }
        else { const int v = u - 1024, b = v >> 2; hm = v & 3; r0 = (size_t)(NP + 64 * b); kvb = 8 + b; nq = 64; }
        mem_attn_unit(lds, QM + r0 * DM + 256 * hm, MK + (size_t)kvb * 256 * 1024 + 256 * hm, MV + (size_t)kvb * 256 * 1024 + 256 * hm, OM + r0 * DM + 256 * hm, nq, tid);
    }
}

DI void p8_fixup(const Params& p, int tid) {
    const int gt = blockIdx.x * 512 + tid, NGT = gridDim.x * 512;
    const float* gfirst = (const float*)(p.ws + WS_SIDE); const float* vfirst = gfirst + SIDE_ELEMS; const float* glast = vfirst + SIDE_ELEMS;
    bf16_t* Ab = (bf16_t*)(p.ws + WS_AB);
    const float* wconv = p.in[29]; const float* bconv = p.in[30]; const float* st = p.in[9];
    constexpr int C4 = DFF / 4;
    for (int idx = gt; idx < 528 * 2 * C4; idx += NGT) {
        const int c4 = idx % C4, bj = idx / C4, j = bj & 1, blk = bj >> 1, col = 4 * c4;
        const bool start = blk >= 512 || (blk & 63) == 0;
        f32x4 pa, pb;
        if (start) { if (blk >= 512) { const float* s = st + (size_t)(blk - 512) * 2 * DFF + col; pa = *(const f32x4*)s; pb = *(const f32x4*)(s + DFF); } else { pa = (f32x4){0.f, 0.f, 0.f, 0.f}; pb = pa; } }
        else { const float* s = glast + (size_t)(blk - 1) * 2 * DFF + col; pa = *(const f32x4*)s; pb = *(const f32x4*)(s + DFF); }
        const f32x4 g0 = *(const f32x4*)(gfirst + (size_t)blk * 2 * DFF + col), g1 = *(const f32x4*)(gfirst + ((size_t)blk * 2 + 1) * DFF + col);
        const f32x4 gm2 = j == 0 ? pa : pb, gm1 = j == 0 ? pb : g0, gc = j == 0 ? g0 : g1;
        const f32x4 vv = *(const f32x4*)(vfirst + ((size_t)blk * 2 + j) * DFF + col);
        const f32x4 cv = gm2 * *(const f32x4*)(wconv + col) + gm1 * *(const f32x4*)(wconv + DFF + col) + gc * *(const f32x4*)(wconv + 2 * DFF + col) + *(const f32x4*)(bconv + col);
        const f32x4 a = silu_mul(cv, vv);
        *(unsigned long long*)(Ab + (size_t)(blk * 64 + j) * DFF + col) = (unsigned long long)pk2(a[0], a[1]) | ((unsigned long long)pk2(a[2], a[3]) << 32);
    }
    for (int idx = gt; idx < 24 * 2 * C4; idx += NGT) {
        const int c4 = idx % C4, bj = idx / C4, j = bj & 1, b = bj >> 1, col = 4 * c4;
        const int blk = b < 8 ? 64 * b + 63 : 512 + (b - 8);
        const f32x4 g = *(const f32x4*)(glast + ((size_t)blk * 2 + j) * DFF + col);
        float* dst = b < 8 ? p.out + OFF_CV_P + ((size_t)b * 2 + j) * DFF + col : p.out + OFF_CV_S + ((size_t)(b - 8) * 2 + j) * DFF + col;
        *(f32x4*)dst = g;
    }
}


template <int NSPLIT, class Fin>
DI void splitk_tail(LAS unsigned char* lds, const bf16_t* A, const bf16_t* Bt, int Kpitch, int ntp, float* parts_base, unsigned* cnt_base, const Fin& fin, int wave_s) {
    if ((int)blockIdx.x >= 16 * NSPLIT) return;
    const int pc = (int)blockIdx.x, un = pc / NSPLIT, ks = pc % NSPLIT;
    float* parts = parts_base + (size_t)un * NSPLIT * 65536;
    pg8::Gemm g2{A + 64 * ntp * ks, Bt + 64 * ntp * ks, MT, 1024, Kpitch, ntp};
    OneUnit S2{128 + (un >> 2), un & 3};
    EpiPartial E2{parts + (size_t)ks * 65536};
    pg8::gemm_phase<EpiPartial, OneUnit, true, true>(lds, g2, S2, E2, fresh_tid(wave_s));
    gbar(cnt_base + un, (unsigned)NSPLIT, fresh_tid(wave_s));
    constexpr int RP = (256 + NSPLIT - 1) / NSPLIT, NJ = RP * 64 / 512;
    const int t = fresh_tid(wave_s), r0 = ks * RP;
#pragma unroll
    for (int j = 0; j < NJ; ++j) { const int e = t + 512 * j, rr = r0 + (e >> 6), c4 = (e & 63) * 4;
        if (rr < 256) { f32x4 acc_ = {0.f, 0.f, 0.f, 0.f};
#pragma unroll
            for (int q = 0; q < NSPLIT; ++q) acc_ += *(const f32x4*)(parts + (size_t)q * 65536 + rr * 256 + c4);
            fin((128 + (un >> 2)) * 256 + rr, (un & 3) * 256 + c4, acc_, t & 63); } }
}
DI f32x4 bf4_to_f32(unsigned long long w) { f32x4 a; const unsigned lo = (unsigned)w, hi = (unsigned)(w >> 32);
    a[0] = __uint_as_float(lo << 16); a[1] = __uint_as_float(lo & 0xffff0000u); a[2] = __uint_as_float(hi << 16); a[3] = __uint_as_float(hi & 0xffff0000u); return a; }
template <bool SRC16>
struct FinRes {
    const float* src; const bf16_t* src16; bf16_t* XB; float* ss;
    DI void operator()(int row, int col, const f32x4& a, int lane) const {
        f32x4 r;
        if (SRC16) r = bf4_to_f32(*(const unsigned long long*)(src16 + (size_t)row * DM + col)); else r = *(const f32x4*)(src + (size_t)(row - NP) * DM + col);
        const f32x4 v = r + a;
        *(unsigned long long*)(XB + (size_t)row * DM + col) = (unsigned long long)pk2(v[0], v[1]) | ((unsigned long long)pk2(v[2], v[3]) << 32);
        float sq = (v[0] * v[0] + v[1] * v[1]) + (v[2] * v[2] + v[3] * v[3]); sq = wave_sum(sq);
        if (lane == 0) atomicAdd(ss + row, sq);
    }
};
struct FinScale {
    const float* ss; bf16_t* O;
    DI void operator()(int row, int col, const f32x4& a, int) const {
        const float rs = rsqrtf(ss[row] * (1.f / DM) + EPS);
        *(unsigned long long*)(O + (size_t)row * DM + col) = (unsigned long long)pk2(a[0] * rs, a[1] * rs) | ((unsigned long long)pk2(a[2] * rs, a[3] * rs) << 32);
    }
};
struct FinDown {
    const bf16_t* X2B; float* out;
    DI void operator()(int row, int col, const f32x4& a, int) const { const size_t off = (size_t)row * DM + col;
        *(f32x4*)(out + off) = bf4_to_f32(*(const unsigned long long*)(X2B + off)) + a; }
};

__global__ void __launch_bounds__(512, 2) mega_fwd(Params p) {
    extern __shared__ __attribute__((aligned(16))) unsigned char lds_raw[];
    LAS unsigned char* lds = (LAS unsigned char*)lds_raw;
    const int wave_s = __builtin_amdgcn_readfirstlane((int)threadIdx.x >> 6), G = gridDim.x;
    unsigned char* ws = p.ws;
    unsigned* gctr = (unsigned*)(ws + WS_CTR) + 32; unsigned bar_k = 0;
#define TID() fresh_tid(wave_s)

#ifndef PM
#define PM 0x3ff
#endif
#ifndef PROBE_LO
#define PROBE_LO -1
#define PROBE_HI -1
#endif
#define STAMP(k) do { if (PROBE_LO >= 0 && blockIdx.x == 0 && TID() == 0) { unsigned long long* tsw = (unsigned long long*)(p.ws + WS_CTR + 1024); \
        if ((k) == PROBE_LO) tsw[0] = __builtin_amdgcn_s_memrealtime(); if ((k) == PROBE_HI + 1) tsw[1] = __builtin_amdgcn_s_memrealtime(); } } while (0)
    STAMP(0);
    if constexpr (PM & 1) p0_prologue(p, lds, TID());
    cg::this_grid().sync();
    STAMP(1);
    if constexpr ((PM >> 1) & 1) {
        pg8::Gemm g{(const bf16_t*)(ws + WS_XB), (const bf16_t*)(ws + WS_WIN), MA, 5120, 1024};
        DualOrder S; S.nM = 132; S.nN = 12; S.n1 = 132 * 12; S.G = G; S.c = (int)blockIdx.x; S.nM2 = 8; S.n2 = 64; S.pm_off = 132; S.pn_off = 12;
        EpiInProj E{(const float*)(ws + WS_RSTD1), (bf16_t*)(ws + WS_P), p.out, (float*)(ws + WS_MEMRAW), (const float*)(ws + WS_GTAB)};
        pg8::gemm_phase<EpiInProj, DualOrder, true, true>(lds, g, S, E, TID());
        if (blockIdx.x < 192) cumsum_bh(p, lds, TID(), (int)blockIdx.x);
    }
    gbar(gctr, (++bar_k) * (unsigned)G, TID());
    STAMP(2);
#ifdef P2EXP
    { if (blockIdx.x == 0 && TID() == 0) ((unsigned long long*)(p.ws + WS_CTR + 1024))[0] = __builtin_amdgcn_s_memrealtime();
      p2_attention<P2EXP>(p, lds, TID());
      gbar(gctr, (++bar_k) * (unsigned)G, TID());
      if (blockIdx.x == 0 && TID() == 0) ((unsigned long long*)(p.ws + WS_CTR + 1024))[1] = __builtin_amdgcn_s_memrealtime(); }
#endif
    if constexpr ((PM >> 2) & 1) p2_attention<0>(p, lds, TID());
    gbar(gctr, (++bar_k) * (unsigned)G, TID());
    STAMP(3);
    if constexpr ((PM >> 3) & 1) {
        pg8::Gemm g{(const bf16_t*)(ws + WS_O), (const bf16_t*)(ws + WS_WO), MT, 1024, 1024};
        pg8::StaticOrder S; S.init(MT, 1024, G, (int)blockIdx.x);
        EpiRes<true> E{nullptr, nullptr, (const bf16_t*)(ws + WS_XB), (bf16_t*)(ws + WS_X1B), (float*)(ws + WS_SS2)};
        pg8::gemm_phase<EpiRes<true>, pg8::StaticOrder, true, true>(lds, g, S, E, TID());
    }
    gbar(gctr, (++bar_k) * (unsigned)G, TID());
    STAMP(4);
    if constexpr ((PM >> 4) & 1) {
        pg8::Gemm g{(const bf16_t*)(ws + WS_X1B), (const bf16_t*)(ws + WS_WMQ), MT, 1024, 1024};
        pg8::StaticOrder S; S.init(MT, 1024, G, (int)blockIdx.x);
        EpiScaleBf16 E{(const float*)(ws + WS_SS2), (bf16_t*)(ws + WS_QM)};
        pg8::gemm_phase<EpiScaleBf16, pg8::StaticOrder, true, true>(lds, g, S, E, TID());
    }
    gbar(gctr, (++bar_k) * (unsigned)G, TID());
    STAMP(5);
    if constexpr ((PM >> 5) & 1) p5_mem_attention(p, lds, TID());
    gbar(gctr, (++bar_k) * (unsigned)G, TID());
    STAMP(6);
    if constexpr ((PM >> 6) & 1) {
        pg8::Gemm g{(const bf16_t*)(ws + WS_OM), (const bf16_t*)(ws + WS_WMO), MT, 1024, 1024};
        pg8::StaticOrder S; S.init(MT, 1024, G, (int)blockIdx.x);
        EpiRes<true> E{nullptr, nullptr, (const bf16_t*)(ws + WS_X1B), (bf16_t*)(ws + WS_X2B), (float*)(ws + WS_SS3)};
        pg8::gemm_phase<EpiRes<true>, pg8::StaticOrder, true, true>(lds, g, S, E, TID());
    }
    gbar(gctr, (++bar_k) * (unsigned)G, TID());
    STAMP(7);
    if constexpr ((PM >> 7) & 1) {
        pg8::Gemm g{(const bf16_t*)(ws + WS_X2B), (const bf16_t*)(ws + WS_WUP), MT, 2 * DFF, 1024};
        pg8::StaticOrder S; S.init(MT, 2 * DFF, G, (int)blockIdx.x);
        float* side = (float*)(ws + WS_SIDE);
        EpiUp E{(const float*)(ws + WS_SS3), p.in[29], p.in[30], (bf16_t*)(ws + WS_AB), side, side + SIDE_ELEMS, side + 2 * SIDE_ELEMS};
        pg8::gemm_phase<EpiUp, pg8::StaticOrder, true, true>(lds, g, S, E, TID());
    }
    gbar(gctr, (++bar_k) * (unsigned)G, TID());
    STAMP(8);
    if constexpr ((PM >> 8) & 1) p8_fixup(p, TID());
    gbar(gctr, (++bar_k) * (unsigned)G, TID());
    STAMP(9);
    if constexpr ((PM >> 9) & 1) {
        pg8::Gemm g{(const bf16_t*)(ws + WS_AB), (const bf16_t*)(ws + WS_WDN), NP, 1024, DFF};
        pg8::StaticOrder S; S.init(NP, 1024, G, (int)blockIdx.x);
        EpiDown E{(const bf16_t*)(ws + WS_X2B), p.out};
        pg8::gemm_phase<EpiDown, pg8::StaticOrder, true, true>(lds, g, S, E, TID());
        { FinDown F{(const bf16_t*)(ws + WS_X2B), p.out};
          splitk_tail<11>(lds, (const bf16_t*)(ws + WS_AB), (const bf16_t*)(ws + WS_WDN), DFF, 4, (float*)(ws + WS_SIDE), (unsigned*)(ws + WS_CTR) + 112, F, wave_s); }
    }
    if (PROBE_LO >= 0) { gbar(gctr, (++bar_k) * (unsigned)G, TID()); STAMP(10);
        if (blockIdx.x == 0 && TID() == 0) { volatile unsigned long long* tsw = (volatile unsigned long long*)(p.ws + WS_CTR + 1024); const unsigned long long te = __builtin_amdgcn_s_memrealtime(), d = 4ull * (tsw[1] - tsw[0]); while (__builtin_amdgcn_s_memrealtime() - te < d) __builtin_amdgcn_s_sleep(32); } }
}

extern "C" void kernel_launch(void* const* d_in, const int* in_sizes, int n_in, void* d_out, int out_size, void* d_ws, size_t ws_size, hipStream_t stream) {
    static int grid = 0;
    if (grid == 0) {
        if (n_in != 32 || (size_t)out_size != OUT_TOTAL || ws_size < WS_END) { fprintf(stderr, "kernel_launch: unexpected shapes: n_in %d out %d ws %zu\n", n_in, out_size, ws_size); grid = -1; return; }
        int dev = 0, cus = 0, per_cu = 0;
        hipGetDevice(&dev); hipDeviceGetAttribute(&cus, hipDeviceAttributeMultiprocessorCount, dev);
        if (hipFuncSetAttribute((const void*)mega_fwd, hipFuncAttributeMaxDynamicSharedMemorySize, LDS_BYTES) != hipSuccess) { fprintf(stderr, "kernel_launch: hipFuncSetAttribute failed\n"); grid = -1; return; }
        if (hipOccupancyMaxActiveBlocksPerMultiprocessor(&per_cu, (const void*)mega_fwd, 512, LDS_BYTES) != hipSuccess || per_cu < 1) { fprintf(stderr, "kernel_launch: occupancy query says %d\n", per_cu); per_cu = 1; }
        (void)hipGetLastError();
        grid = cus;
    }
    if (grid < 0) return;
    Params p{};
    for (int i = 0; i < 32; ++i) p.in[i] = (const float*)d_in[i];
    p.out = (float*)d_out; p.ws = (unsigned char*)d_ws;
    void* args[] = {&p};
    hipError_t e = hipLaunchCooperativeKernel((const void*)mega_fwd, dim3(grid), dim3(512), args, LDS_BYTES, stream);
    if (e != hipSuccess) fprintf(stderr, "cooperative launch failed: %s (grid %d)\n", hipGetErrorString(e), grid);
}
```

```cpp
#include <hip/hip_runtime.h>
#include <hip/hip_cooperative_groups.h>
#include <cstdio>
#include <cstdint>
namespace cg = cooperative_groups;
namespace pg8 {
#define PG8_LAS __attribute__((address_space(3)))
typedef unsigned short bf16_t;
typedef short bf16x8 __attribute__((ext_vector_type(8)));
typedef float f32x4 __attribute__((ext_vector_type(4)));
typedef unsigned u32x4 __attribute__((ext_vector_type(4)));
constexpr int BM = 256, BK = 64, HALF = 128, HTB = HALF * BK * 2  , STAGE_BYTES = 8 * HTB, NXCD = 8, WGM = 8;

__host__ __device__ __forceinline__ int lds_byte(int r, int c) { const int st = (r >> 4) * 2 + (c >> 5), rr = r & 15, cc = c & 31, ob = rr * 64 + cc * 2; return st * 1024 + (ob ^ (((ob >> 9) & 1) << 5)); }
__host__ __device__ __forceinline__ void stage_rc(int b, int& R, int& C) { const int st = b / 1024, sb = b % 1024, swz = sb ^ (((sb >> 9) & 1) << 5); R = (st >> 1) * 16 + swz / 64; C = (st & 1) * 32 + (swz % 64) / 2; }
__host__ __device__ __forceinline__ int perm32(int rho) { const int n = rho >> 4, i = rho & 15; return 8 * (i >> 2) + 4 * n + (i & 3); }

struct Unit { int pm, pn; };
struct Gemm { const bf16_t* A; const bf16_t* Bt; int M, N, K; int nt; };

struct StaticOrder {
    int nM, nN, nwg, G, c;
    __host__ __device__ void init(int M, int N, int G_, int c_) { nM = M / BM; nN = N / BM; nwg = nM * nN; G = G_; c = c_; }
    __host__ __device__ bool next(int i, Unit& u) const {
        const long L = (long)i * G + c; if (L >= nwg) return false;
        int wgid = (int)L; { const int q = nwg / NXCD, r = nwg % NXCD, xcd = wgid % NXCD, off = wgid / NXCD; wgid = (xcd < r ? xcd * (q + 1) : r * (q + 1) + (xcd - r) * q) + off; }
        const int nig = WGM * nN, gid = wgid / nig, fm = gid * WGM, gsz = (nM - fm) < WGM ? (nM - fm) : WGM;
        u.pm = fm + ((wgid % nig) % gsz); u.pn = (wgid % nig) / gsz; return true;
    }
    __device__ __forceinline__ void a_ready(const Unit&) const {}
    __device__ __forceinline__ void done(const Unit&) const {}
};

typedef float f32x2 __attribute__((ext_vector_type(2)));
__device__ __forceinline__ unsigned cvt_pk_bf16(float lo, float hi) { unsigned r; asm volatile("v_cvt_pk_bf16_f32 %0, %1, %2" : "=v"(r) : "v"(lo), "v"(hi)); return r; }
template <class Epi, class Sched, bool ALIGN_EPI = false, bool SP2 = false>
__device__ __forceinline__ void gemm_phase(PG8_LAS unsigned char* lds, const Gemm g, const Sched& S, const Epi& E, const int tid_in) {
    int tid_ = tid_in; asm volatile("" : "+v"(tid_));
    const int tid = tid_, wid = __builtin_amdgcn_readfirstlane(tid >> 6), lane = tid & 63, wr = wid >> 2, wc = wid & 3, fr = lane & 15, fq = lane >> 4;
    const int K = g.K, nt = g.nt > 0 ? g.nt : K / BK;
    unsigned voffA[2], voffB[2];
#pragma unroll
    for (int i = 0; i < 2; ++i) { int R, C; stage_rc(tid * 16 + i * 8192, R, C); const int Rb = Epi::PERM ? ((R & ~31) + perm32(R & 31)) : R;
        voffA[i] = (unsigned)(R * K + C) * 2u; voffB[i] = (unsigned)(Rb * K + C) * 2u; }
    const size_t kstep = (size_t)(BK * 2);
    const size_t hstep = (size_t)HALF * K * 2;
    const size_t tstep = 2 * hstep;
    const unsigned ldsw = (unsigned)wid * 1024u;
    const int aoff = lds_byte(wr * 64 + fr, fq * 8), boff = lds_byte(wc * 32 + fr, fq * 8);
#define PG8_SA(b, h) (((b) * 2 + (h)) * HTB)
#define PG8_SB(b, h) ((4 + (b) * 2 + (h)) * HTB)
#define PG8_STAGE(bufoff, gbase, voff) do { _Pragma("unroll") for (int _i = 0; _i < 2; ++_i) \
        __builtin_amdgcn_global_load_lds((const unsigned*)((const char*)(gbase) + (voff)[_i]), (PG8_LAS unsigned*)(lds + (bufoff) + ldsw + _i * 8192), 16, 0, 0); } while (0)
#define PG8_LDA(dst, b, h) do { _Pragma("unroll") for (int m = 0; m < 4; ++m) _Pragma("unroll") for (int k = 0; k < 2; ++k) dst[m][k] = *(const PG8_LAS bf16x8*)(lds + PG8_SA(b, h) + aoff + m * 2048 + k * 1024); } while (0)
#define PG8_LDB(dst, b, h) do { _Pragma("unroll") for (int n = 0; n < 2; ++n) _Pragma("unroll") for (int k = 0; k < 2; ++k) dst[n][k] = *(const PG8_LAS bf16x8*)(lds + PG8_SB(b, h) + boff + n * 2048 + k * 1024); } while (0)
#define PG8_MMA(ai, bj, At, Bt) do { __builtin_amdgcn_s_setprio(1); _Pragma("unroll") for (int m = 0; m < 4; ++m) _Pragma("unroll") for (int n = 0; n < 2; ++n) _Pragma("unroll") for (int k = 0; k < 2; ++k) \
        acc[ai][bj][m][n] = __builtin_amdgcn_mfma_f32_16x16x32_bf16(Bt[n][k], At[m][k], acc[ai][bj][m][n], 0, 0, 0); __builtin_amdgcn_s_setprio(0); } while (0)
#define PG8_WAIT_V(n) asm volatile("s_waitcnt vmcnt(" #n ")" ::: "memory")
#define PG8_WAIT_L(n) asm volatile("s_waitcnt lgkmcnt(" #n ")" ::: "memory")
#define PG8_BAR __builtin_amdgcn_s_barrier()
#define PG8_SCHED __builtin_amdgcn_sched_barrier(0)
    Unit cur, nxt; int ui = 0;
    if (!S.next(0, cur)) return;
    f32x4 acc[2][2][4][2];
#pragma unroll
    for (int a = 0; a < 2; ++a)
#pragma unroll
        for (int b = 0; b < 2; ++b)
#pragma unroll
            for (int m = 0; m < 4; ++m)
#pragma unroll
                for (int n = 0; n < 2; ++n) acc[a][b][m][n] = (f32x4){0.f, 0.f, 0.f, 0.f};
    bf16x8 At[4][2], B0[2][2], B1[2][2];
    const char* cA = (const char*)g.A + (size_t)cur.pm * tstep; const char* cB = (const char*)g.Bt + (size_t)cur.pn * tstep;
    S.a_ready(cur);
    if constexpr (SP2) {
        PG8_STAGE(PG8_SB(0, 0), cB, voffB); PG8_STAGE(PG8_SB(0, 1), cB + hstep, voffB); PG8_STAGE(PG8_SA(0, 0), cA, voffA); PG8_STAGE(PG8_SA(0, 1), cA + hstep, voffA);
        if (wr == 1) PG8_BAR;
        PG8_WAIT_V(2); PG8_BAR;
        PG8_STAGE(PG8_SB(1, 0), cB + kstep, voffB); PG8_STAGE(PG8_SA(1, 0), cA + kstep, voffA); PG8_STAGE(PG8_SB(1, 1), cB + hstep + kstep, voffB);
        PG8_WAIT_V(6); PG8_BAR;
    } else {
        PG8_STAGE(PG8_SB(0, 0), cB, voffB); PG8_STAGE(PG8_SA(0, 0), cA, voffA); PG8_STAGE(PG8_SB(0, 1), cB + hstep, voffB); PG8_STAGE(PG8_SA(0, 1), cA + hstep, voffA);
        if (wr == 1) PG8_BAR;
        PG8_WAIT_V(4); PG8_BAR;
        PG8_STAGE(PG8_SB(1, 0), cB + kstep, voffB); PG8_STAGE(PG8_SA(1, 0), cA + kstep, voffA); PG8_STAGE(PG8_SB(1, 1), cB + hstep + kstep, voffB);
        PG8_WAIT_V(6); PG8_BAR;
    }
    for (;;) {
        const bool has_next = S.next(ui + 1, nxt);
        const char* nA = has_next ? (const char*)g.A + (size_t)nxt.pm * tstep : cA; const char* nB = has_next ? (const char*)g.Bt + (size_t)nxt.pn * tstep : cB;
        for (int t = 0; t < nt; t += 2) {
            const bool last = (t == nt - 2);
            const char* a1 = cA + (size_t)(t + 1) * kstep;
            const char* a2 = last ? nA : cA + (size_t)(t + 2) * kstep; const char* b2 = last ? nB : cB + (size_t)(t + 2) * kstep;
            const char* a3 = a2 + kstep; const char* b3 = b2 + kstep;
            if (last && has_next) S.a_ready(nxt);
            if constexpr (SP2) {
            PG8_LDB(B0, 0, 0); PG8_LDB(B1, 0, 1); PG8_SCHED; PG8_LDA(At, 0, 0); PG8_STAGE(PG8_SA(1, 1), a1 + hstep, voffA);
            PG8_WAIT_V(8); PG8_WAIT_L(0); PG8_BAR; PG8_MMA(0, 0, At, B0); PG8_MMA(0, 1, At, B1); PG8_BAR; PG8_SCHED;
            PG8_LDA(At, 0, 1); PG8_STAGE(PG8_SB(0, 0), b2, voffB); PG8_STAGE(PG8_SB(0, 1), b2 + hstep, voffB); PG8_STAGE(PG8_SA(0, 0), a2, voffA);
            PG8_WAIT_V(8); PG8_WAIT_L(0); PG8_BAR; PG8_MMA(1, 0, At, B0); PG8_MMA(1, 1, At, B1); PG8_BAR; PG8_SCHED;
            PG8_LDB(B0, 1, 0); PG8_LDB(B1, 1, 1); PG8_SCHED; PG8_LDA(At, 1, 0); PG8_STAGE(PG8_SA(0, 1), a2 + hstep, voffA);
            PG8_WAIT_V(8); PG8_WAIT_L(0); PG8_BAR; PG8_MMA(0, 0, At, B0); PG8_MMA(0, 1, At, B1); PG8_BAR; PG8_SCHED;
            PG8_LDA(At, 1, 1); PG8_STAGE(PG8_SB(1, 0), b3, voffB); PG8_STAGE(PG8_SB(1, 1), b3 + hstep, voffB); PG8_STAGE(PG8_SA(1, 0), a3, voffA);
            PG8_WAIT_V(8); PG8_WAIT_L(0); PG8_BAR; PG8_MMA(1, 0, At, B0); PG8_MMA(1, 1, At, B1); PG8_BAR; PG8_SCHED;
            } else {
            PG8_LDB(B0, 0, 0); PG8_SCHED; PG8_LDA(At, 0, 0); PG8_STAGE(PG8_SA(1, 1), a1 + hstep, voffA);
            PG8_WAIT_L(8); PG8_BAR; PG8_WAIT_L(0); PG8_MMA(0, 0, At, B0); PG8_BAR; PG8_SCHED;
            PG8_LDB(B1, 0, 1); PG8_STAGE(PG8_SB(0, 0), b2, voffB);
            PG8_BAR; PG8_WAIT_L(0); PG8_MMA(0, 1, At, B1); PG8_BAR;
            PG8_LDA(At, 0, 1); PG8_STAGE(PG8_SA(0, 0), a2, voffA);
            PG8_BAR; PG8_WAIT_L(0); PG8_MMA(1, 0, At, B0); PG8_BAR; PG8_SCHED;
            PG8_STAGE(PG8_SB(0, 1), b2 + hstep, voffB);
            PG8_WAIT_V(6); PG8_BAR; PG8_MMA(1, 1, At, B1); PG8_BAR;
            PG8_LDB(B0, 1, 0); PG8_SCHED; PG8_LDA(At, 1, 0); PG8_STAGE(PG8_SA(0, 1), a2 + hstep, voffA);
            PG8_WAIT_L(8); PG8_BAR; PG8_WAIT_L(0); PG8_MMA(0, 0, At, B0); PG8_BAR; PG8_SCHED;
            PG8_LDB(B1, 1, 1); PG8_STAGE(PG8_SB(1, 0), b3, voffB);
            PG8_BAR; PG8_WAIT_L(0); PG8_MMA(0, 1, At, B1); PG8_BAR;
            PG8_LDA(At, 1, 1); PG8_STAGE(PG8_SA(1, 0), a3, voffA);
            PG8_BAR; PG8_WAIT_L(0); PG8_MMA(1, 0, At, B0); PG8_BAR; PG8_SCHED;
            PG8_STAGE(PG8_SB(1, 1), b3 + hstep, voffB);
            PG8_WAIT_V(6); PG8_BAR; PG8_MMA(1, 1, At, B1); PG8_BAR;
            }
        }
        if constexpr (ALIGN_EPI) { if (wr == 0) PG8_BAR; }
        if constexpr (!Epi::AFTER_DRAIN) { E(acc, cur, wr, wc, fr, fq); S.done(cur); }
        if (!has_next) break;
#pragma unroll
        for (int a = 0; a < 2; ++a)
#pragma unroll
            for (int b = 0; b < 2; ++b)
#pragma unroll
                for (int m = 0; m < 4; ++m)
#pragma unroll
                    for (int n = 0; n < 2; ++n) acc[a][b][m][n] = (f32x4){0.f, 0.f, 0.f, 0.f};
        cur = nxt; cA = nA; cB = nB; ++ui;
        if constexpr (ALIGN_EPI) { if (wr == 1) PG8_BAR; }
    }
    PG8_WAIT_V(0);
    if constexpr (!ALIGN_EPI) { if (wr == 0) PG8_BAR; }
    PG8_BAR;
    if constexpr (Epi::AFTER_DRAIN) { E.fused(acc, cur, wr, wc, fr, fq, lds, wid, lane); S.done(cur); }
#undef PG8_SA
#undef PG8_SB
#undef PG8_STAGE
#undef PG8_LDA
#undef PG8_LDB
#undef PG8_MMA
#undef PG8_WAIT_V
#undef PG8_WAIT_L
#undef PG8_BAR
#undef PG8_SCHED
}
}

#define LAS __attribute__((address_space(3)))
using pg8::bf16_t; using pg8::bf16x8; using pg8::f32x4; using pg8::u32x4; using pg8::Unit;
typedef float f32x16 __attribute__((ext_vector_type(16)));
typedef short s16x4 __attribute__((ext_vector_type(4)));
typedef float f32x2v __attribute__((ext_vector_type(2)));
typedef __bf16 bf16x2v __attribute__((ext_vector_type(2)));
#define DI __device__ __forceinline__
#define LDS_WAIT() asm volatile("s_waitcnt lgkmcnt(0)" ::: "memory")

constexpr int DM = 1024, NP = 32768, NS = 1024, MT = NP + NS, MEMR = 2048, MA = MT + MEMR, DFF = 2816, NQKV = 3072;
constexpr float EPS = 1e-6f, LOG2E = 1.44269504088896f;
constexpr float QSCALE = 0.125f * LOG2E;
constexpr size_t OFF_Y = 0;
constexpr size_t OFF_AK_P = 34603008, OFF_AV_P = 36700160, OFF_BK_P = 38797312, OFF_BV_P = 55574528, OFF_BL_P = 72351744;
constexpr size_t OFF_MK_P = 72613888, OFF_MV_P = 74711040, OFF_CV_P = 76808192;
constexpr size_t OFF_AK_S = 76853248, OFF_AV_S = 77377536, OFF_BK_S = 77901824, OFF_BV_S = 78426112, OFF_BL_S = 78950400, OFF_CV_S = 78958592;
constexpr size_t OUT_TOTAL = 79048704;
constexpr size_t MiB = 1u << 20;
constexpr size_t WS_WIN = 0, WS_WO = 10 * MiB, WS_WMQ = 12 * MiB, WS_WMO = 14 * MiB, WS_WUP = 16 * MiB, WS_WDN = 28 * MiB;
constexpr size_t WS_RSTD1 = 34 * MiB, WS_SS2 = 34 * MiB + 256 * 1024, WS_SS3 = 34 * MiB + 512 * 1024, WS_CTR = 34 * MiB + 768 * 1024;
constexpr size_t WS_GTAB = 34 * MiB + 800 * 1024;
constexpr size_t WS_CUMP = 35 * MiB, WS_CUMS = 36 * MiB;
constexpr size_t WS_MK = 40 * MiB, WS_MV = 52 * MiB, WS_MEMRAW = 64 * MiB;
constexpr size_t WS_XB = 80 * MiB, WS_P = 150 * MiB, WS_O = 348 * MiB;
constexpr size_t WS_X1B = 80 * MiB, WS_QM = 146 * MiB, WS_OM = 212 * MiB, WS_X2B = 278 * MiB;
constexpr size_t WS_AB = 80 * MiB, WS_SIDE = 348 * MiB;
constexpr size_t SIDE_ELEMS = (size_t)528 * 2 * DFF;
constexpr size_t WS_END = 414 * MiB;
constexpr int LDS_BYTES = 143360 + 256;
constexpr int LDS_NEXT = 143360;

struct Params { const float* in[32]; float* out; unsigned char* ws; };

DI int fresh_tid(int wave_s) {
    int w = wave_s; unsigned m = ~0u; asm volatile("" : "+s"(w), "+s"(m));
    int t = w * 64 + (int)__builtin_amdgcn_mbcnt_hi(m, __builtin_amdgcn_mbcnt_lo(m, 0u)); asm volatile("" : "+v"(t)); return t; }
DI unsigned pk2(float lo, float hi) { f32x2v v = {lo, hi}; bf16x2v b = __builtin_convertvector(v, bf16x2v); return __builtin_bit_cast(unsigned, b); }
DI float bf2f(unsigned short s) { return __uint_as_float(((unsigned)s) << 16); }
DI float red_max32(float x) { auto r = __builtin_amdgcn_permlane32_swap(__float_as_uint(x), __float_as_uint(x), false, false); return fmaxf(__uint_as_float(r[0]), __uint_as_float(r[1])); }
DI float red_sum32(float x) { auto r = __builtin_amdgcn_permlane32_swap(__float_as_uint(x), __float_as_uint(x), false, false); return __uint_as_float(r[0]) + __uint_as_float(r[1]); }
DI float red_max16(float x) { auto r = __builtin_amdgcn_permlane16_swap(__float_as_uint(x), __float_as_uint(x), false, false); return fmaxf(__uint_as_float(r[0]), __uint_as_float(r[1])); }
DI float red_sum16(float x) { auto r = __builtin_amdgcn_permlane16_swap(__float_as_uint(x), __float_as_uint(x), false, false); return __uint_as_float(r[0]) + __uint_as_float(r[1]); }
template <int CTRL> DI float dpp_mov(float x) { return __uint_as_float((unsigned)__builtin_amdgcn_update_dpp(0, (int)__float_as_uint(x), CTRL, 0xf, 0xf, false)); }
DI float row16_sum(float v) { v += dpp_mov<0x128>(v); v += dpp_mov<0x124>(v); v += dpp_mov<0x122>(v); v += dpp_mov<0x121>(v); return v; }
DI float wave_sum(float v) { return red_sum32(red_sum16(row16_sum(v))); }
DI float wave_max(float v) { v = fmaxf(v, dpp_mov<0x128>(v)); v = fmaxf(v, dpp_mov<0x124>(v)); v = fmaxf(v, dpp_mov<0x122>(v)); v = fmaxf(v, dpp_mov<0x121>(v)); return red_max32(red_max16(v)); }
DI float lane_read(float x, int src_lane) { return __uint_as_float((unsigned)__builtin_amdgcn_ds_bpermute(src_lane << 2, (int)__float_as_uint(x))); }
DI u32x4 pack8(const f32x4& a, const f32x4& b) { u32x4 w; w.x = pk2(a[0], a[1]); w.y = pk2(a[2], a[3]); w.z = pk2(b[0], b[1]); w.w = pk2(b[2], b[3]); return w; }

DI void transpose_item(const float* W, int ldw, int K, const float* gk, bf16_t* WT, int destrow0, int k0, int n0, LAS float* scr, int lane) {
    float tv[32];
#pragma unroll
    for (int i = 0; i < 32; ++i) { const int kk = 2 * i + (lane >> 5); tv[i] = W[(size_t)(k0 + kk) * ldw + n0 + (lane & 31)]; }
#pragma unroll
    for (int i = 0; i < 32; ++i) { const int kk = 2 * i + (lane >> 5); float v = tv[i]; if (gk) v *= gk[k0 + kk]; scr[kk * 33 + (lane & 31)] = v; }
    LDS_WAIT(); asm volatile("" ::: "memory");
    const int c = lane & 7;
#pragma unroll
    for (int j = 0; j < 4; ++j) { const int n = (lane >> 3) + 8 * j; const LAS float* s = scr + (8 * c) * 33 + n;
        u32x4 o; o.x = pk2(s[0 * 33], s[1 * 33]); o.y = pk2(s[2 * 33], s[3 * 33]); o.z = pk2(s[4 * 33], s[5 * 33]); o.w = pk2(s[6 * 33], s[7 * 33]);
        *(u32x4*)(WT + (size_t)(destrow0 + n) * K + k0 + 8 * c) = o; }
    LDS_WAIT(); asm volatile("" ::: "memory");
}

DI void p0_prologue(const Params& p, LAS unsigned char* lds, int tid) {
    const int lane = tid & 63, wave = tid >> 6, G = gridDim.x;
    const int gw = blockIdx.x * 8 + wave, NGW = G * 8;
    const int gt = blockIdx.x * 512 + tid, NGT = G * 512;
    unsigned char* ws = p.ws;
    { float* ss2 = (float*)(ws + WS_SS2); float* ss3 = (float*)(ws + WS_SS3);
      for (int i = gt; i < MT; i += NGT) { ss2[i] = 0.f; ss3[i] = 0.f; }
      if (gt < 128) ((unsigned*)(ws + WS_CTR))[gt] = 0u;
      if (gt < 384) { const int ty = gt >> 6, d = gt & 63; ((float*)(ws + WS_GTAB))[gt] = ty == 0 ? p.in[13][d] : ty == 1 ? p.in[14][d] : ty == 3 ? p.in[16][d] : ty == 4 ? p.in[17][d] : 1.f; } }
    LAS float* wfl = (LAS float*)(lds + 73728);
    { const float* w_in = p.in[11]; const float* g1 = p.in[19];
      for (int e = tid; e < 8192; e += 512) { const int c = e >> 10, k = e & 1023; wfl[e] = w_in[(size_t)k * 3080 + 3072 + c] * g1[k]; } }
    __syncthreads();
    LAS float* scr = (LAS float*)(lds + wave * 8448);
    {
        constexpr int I_IN = 16 * 96, I_MKV = 16 * 64, I_SQ = 16 * 32, I_UP = 16 * 176, I_DN = 44 * 32;
        constexpr int NITEMS = I_IN + I_MKV + 3 * I_SQ + I_UP + I_DN;
        bf16_t* WTin = (bf16_t*)(ws + WS_WIN);
        for (int it = gw; it < NITEMS; it += NGW) {
            int r = it;
            if (r < I_IN) { const int kb = r / 96, nb = r % 96, n0 = 32 * nb;
                const int T = n0 >> 8, wc = (n0 >> 6) & 3, bj = (n0 >> 5) & 1;
                transpose_item(p.in[11], 3080, 1024, p.in[19], WTin, 256 * T + 128 * bj + 32 * wc, 64 * kb, n0, scr, lane); continue; } r -= I_IN;
            if (r < I_MKV) { const int kb = r / 64, nb = r % 64; transpose_item(p.in[23], 2048, 1024, p.in[21], WTin, 3072 + 32 * nb, 64 * kb, 32 * nb, scr, lane); continue; } r -= I_MKV;
            if (r < I_SQ) { const int kb = r / 32, nb = r % 32; transpose_item(p.in[18], 1024, 1024, nullptr, (bf16_t*)(ws + WS_WO), 32 * nb, 64 * kb, 32 * nb, scr, lane); continue; } r -= I_SQ;
            if (r < I_SQ) { const int kb = r / 32, nb = r % 32; transpose_item(p.in[22], 1024, 1024, p.in[20], (bf16_t*)(ws + WS_WMQ), 32 * nb, 64 * kb, 32 * nb, scr, lane); continue; } r -= I_SQ;
            if (r < I_SQ) { const int kb = r / 32, nb = r % 32; transpose_item(p.in[26], 1024, 1024, nullptr, (bf16_t*)(ws + WS_WMO), 32 * nb, 64 * kb, 32 * nb, scr, lane); continue; } r -= I_SQ;
            if (r < I_UP) { const int kb = r / 176, nb = r % 176, n0 = 32 * nb;
                const int dest = (n0 < DFF) ? 256 * (n0 >> 7) + (n0 & 127) : 256 * ((n0 - DFF) >> 7) + 128 + ((n0 - DFF) & 127);
                transpose_item(p.in[28], 2 * DFF, 1024, p.in[27], (bf16_t*)(ws + WS_WUP), dest, 64 * kb, n0, scr, lane); continue; } r -= I_UP;
            { const int kb = r / 32, nb = r % 32; transpose_item(p.in[31], 1024, DFF, nullptr, (bf16_t*)(ws + WS_WDN), 32 * nb, 64 * kb, 32 * nb, scr, lane); }
        }
    }
    {
        bf16_t* XB = (bf16_t*)(ws + WS_XB); float* rstd1 = (float*)(ws + WS_RSTD1);
        const float* bfv = p.in[12];
        const int l16 = lane & 15, grp = lane >> 4;
        for (int row4 = gw * 4; row4 < MA; row4 += NGW * 4) {
            const int row = row4 + grp;
            const float* src = row < NP ? p.in[0] + (size_t)row * DM : (row < MT ? p.in[1] + (size_t)(row - NP) * DM : p.in[10] + (size_t)(row - MT) * DM);
            f32x4 v[16]; float ss = 0.f;
#pragma unroll
            for (int j = 0; j < 16; ++j) v[j] = __builtin_nontemporal_load((const f32x4*)src + l16 + 16 * j);
#pragma unroll
            for (int j = 0; j < 16; ++j) ss += (v[j][0] * v[j][0] + v[j][1] * v[j][1]) + (v[j][2] * v[j][2] + v[j][3] * v[j][3]);
            ss = row16_sum(ss);
            const float rstd = rsqrtf(ss * (1.f / DM) + EPS);
            unsigned long long* o8 = (unsigned long long*)(XB + (size_t)row * DM) + l16;
#pragma unroll
            for (int j = 0; j < 16; ++j) o8[16 * j] = (unsigned long long)pk2(v[j][0], v[j][1]) | ((unsigned long long)pk2(v[j][2], v[j][3]) << 32);
            if (l16 == 0) rstd1[row] = rstd;
            if (row4 < MT) {
                float a[8];
#pragma unroll
                for (int c = 0; c < 8; ++c) {
                    float acc_ = 0.f; const LAS f32x4* wp = (const LAS f32x4*)wfl + 256 * c + l16;
#pragma unroll
                    for (int j = 0; j < 16; ++j) { const f32x4 w = wp[16 * j]; acc_ += (v[j][0] * w[0] + v[j][1] * w[1]) + (v[j][2] * w[2] + v[j][3] * w[3]); }
                    acc_ = row16_sum(acc_);
                    a[c] = acc_;
                }
                if (l16 < 8) {
                    const float av = l16 == 0 ? a[0] : l16 == 1 ? a[1] : l16 == 2 ? a[2] : l16 == 3 ? a[3] : l16 == 4 ? a[4] : l16 == 5 ? a[5] : l16 == 6 ? a[6] : a[7];
                    const float z = av * rstd + bfv[l16];
                    const float lf = fminf(z, 0.f) - log1pf(expf(-fabsf(z)));
                    float* dst = row < NP ? p.out + OFF_BL_P + (size_t)row * 8 : p.out + OFF_BL_S + (size_t)(row - NP) * 8;
                    dst[l16] = lf;
                }
            }
        }
    }
    {
        const f32x4* ck = (const f32x4*)p.in[7]; const f32x4* cv = (const f32x4*)p.in[8]; const f32x4* gq = (const f32x4*)p.in[24];
        unsigned long long* mk = (unsigned long long*)(ws + WS_MK) + (size_t)8 * 256 * 1024 / 4;
        unsigned long long* mv = (unsigned long long*)(ws + WS_MV) + (size_t)8 * 256 * 1024 / 4;
        for (int i0 = gt; i0 < 16 * 256 * 1024 / 4; i0 += 4 * NGT) {
            f32x4 kk_[4], vv_[4];
#pragma unroll
            for (int j = 0; j < 4; ++j) { const int i = i0 + j * NGT; if (i < 16 * 256 * 1024 / 4) { kk_[j] = ck[i]; vv_[j] = cv[i]; } }
#pragma unroll
            for (int j = 0; j < 4; ++j) { const int i = i0 + j * NGT; if (i >= 16 * 256 * 1024 / 4) break; const f32x4 g = gq[i & 63]; const f32x4 k = kk_[j] * g, v = vv_[j];
                mk[i] = (unsigned long long)pk2(k[0], k[1]) | ((unsigned long long)pk2(k[2], k[3]) << 32);
                mv[i] = (unsigned long long)pk2(v[0], v[1]) | ((unsigned long long)pk2(v[2], v[3]) << 32); }
        }
    }
    __syncthreads();
}

struct DualOrder {
    int n1, G, c, nM2, n2, pm_off, pn_off, nM, nN;
    DI bool next(int i, Unit& u) const {
        long L = (long)i * G + c;
        if (L < n1) {
            int wgid = (int)L; { const int q = n1 / 8, xcd = wgid % 8, off = wgid / 8; wgid = xcd * q + off; }
            const int nig = 8 * nN, gid = wgid / nig, fm = gid * 8, gsz = (nM - fm) < 8 ? (nM - fm) : 8;
            u.pm = fm + ((wgid % nig) % gsz); u.pn = (wgid % nig) / gsz; return true;
        }
        L -= n1; if (L >= n2) return false;
        u.pm = pm_off + (int)(L % nM2); u.pn = pn_off + (int)(L / nM2); return true;
    }
    DI void a_ready(const Unit&) const {}
    DI void done(const Unit&) const {}
};

struct EpiInProj {
    static constexpr bool PERM = true, AFTER_DRAIN = false;
    const float* rstd1; bf16_t* P; float* out; float* memraw; const float* gtab;
    DI void operator()(const f32x4 (&acc)[2][2][4][2], const Unit& u, int wr, int wc, int fr, int fq) const {
        if (u.pn >= 12) {
#pragma unroll
            for (int ai = 0; ai < 2; ++ai)
#pragma unroll
                for (int m = 0; m < 4; ++m) { const int row = u.pm * 256 + ai * 128 + wr * 64 + m * 16 + fr; const float rs = rstd1[row];
                    float* dst = memraw + (size_t)(row - MT) * 2048 + (u.pn - 12) * 256 + wc * 32 + 8 * fq;
#pragma unroll
                    for (int bj = 0; bj < 2; ++bj) { *(f32x4*)(dst + bj * 128) = acc[ai][bj][m][0] * rs; *(f32x4*)(dst + bj * 128 + 4) = acc[ai][bj][m][1] * rs; } }
            return;
        }
        const int type = u.pn >> 1, head = 4 * (u.pn & 1) + wc;
        const bool isq = (type == 0 || type == 3), isk = (type == 1 || type == 4);
        const float* g = gtab + type * 64;
        f32x4 gv[2][2];
#pragma unroll
        for (int bj = 0; bj < 2; ++bj)
#pragma unroll
            for (int n = 0; n < 2; ++n) gv[bj][n] = *(const f32x4*)(g + 32 * bj + 8 * fq + 4 * n);
#pragma unroll
        for (int ai = 0; ai < 2; ++ai)
#pragma unroll
            for (int m = 0; m < 4; ++m) {
                const int row = u.pm * 256 + ai * 128 + wr * 64 + m * 16 + fr; const float rs = rstd1[row];
                f32x4 v[2][2];
#pragma unroll
                for (int bj = 0; bj < 2; ++bj)
#pragma unroll
                    for (int n = 0; n < 2; ++n) v[bj][n] = acc[ai][bj][m][n] * rs;
                if (isq || isk) {
                    float ss = 0.f;
#pragma unroll
                    for (int bj = 0; bj < 2; ++bj)
#pragma unroll
                        for (int n = 0; n < 2; ++n) ss += (v[bj][n][0] * v[bj][n][0] + v[bj][n][1] * v[bj][n][1]) + (v[bj][n][2] * v[bj][n][2] + v[bj][n][3] * v[bj][n][3]);
                    ss = red_sum32(red_sum16(ss));
                    float r = rsqrtf(ss * (1.f / 64.f) + EPS); if (isq) r *= QSCALE;
#pragma unroll
                    for (int bj = 0; bj < 2; ++bj)
#pragma unroll
                        for (int n = 0; n < 2; ++n) v[bj][n] = v[bj][n] * r * gv[bj][n];
                }
                bf16_t* prow = P + (size_t)row * NQKV + type * 512 + head * 64 + 8 * fq;
#pragma unroll
                for (int bj = 0; bj < 2; ++bj) *(u32x4*)(prow + 32 * bj) = pack8(v[bj][0], v[bj][1]);
                if (!isq) {
                    float* dst = nullptr;
                    if (row < NP) { const int b = row >> 12, t = row & 4095;
                        if (type <= 2) { if (t >= 3584) dst = out + (type == 1 ? OFF_AK_P : OFF_AV_P) + ((size_t)(b * 512 + t - 3584) * 8 + head) * 64; }
                        else dst = out + (type == 4 ? OFF_BK_P : OFF_BV_P) + ((size_t)row * 8 + head) * 64; }
                    else { const int rs_ = row - NP;
                        dst = out + (type == 1 ? OFF_AK_S : type == 2 ? OFF_AV_S : type == 4 ? OFF_BK_S : OFF_BV_S) + ((size_t)rs_ * 8 + head) * 64; }
                    if (dst) {
#pragma unroll
                        for (int bj = 0; bj < 2; ++bj) { *(f32x4*)(dst + 32 * bj + 8 * fq) = v[bj][0]; *(f32x4*)(dst + 32 * bj + 8 * fq + 4) = v[bj][1]; } }
                }
            }
    }
};

DI void bf8_to_f32(const u32x4& w, f32x4& a, f32x4& b) {
    a[0] = __uint_as_float(w.x << 16); a[1] = __uint_as_float(w.x & 0xffff0000u); a[2] = __uint_as_float(w.y << 16); a[3] = __uint_as_float(w.y & 0xffff0000u);
    b[0] = __uint_as_float(w.z << 16); b[1] = __uint_as_float(w.z & 0xffff0000u); b[2] = __uint_as_float(w.w << 16); b[3] = __uint_as_float(w.w & 0xffff0000u);
}
template <bool SRC16>
struct EpiRes {
    static constexpr bool PERM = true, AFTER_DRAIN = false;
    const float* src_p; const float* src_s; const bf16_t* src16; bf16_t* XB; float* ss;
    DI void operator()(const f32x4 (&acc)[2][2][4][2], const Unit& u, int wr, int wc, int fr, int fq) const {
#pragma unroll
        for (int ai = 0; ai < 2; ++ai)
#pragma unroll
            for (int m = 0; m < 4; ++m) {
                const int row = u.pm * 256 + ai * 128 + wr * 64 + m * 16 + fr;
                const float* src = row < NP ? src_p + (size_t)row * DM : src_s + (size_t)(row - NP) * DM;
                float sq = 0.f;
#pragma unroll
                for (int bj = 0; bj < 2; ++bj) { const int col = u.pn * 256 + bj * 128 + wc * 32 + 8 * fq;
                    f32x4 r0, r1;
                    if (SRC16) bf8_to_f32(*(const u32x4*)(src16 + (size_t)row * DM + col), r0, r1);
                    else { r0 = *(const f32x4*)(src + col); r1 = *(const f32x4*)(src + col + 4); }
                    const f32x4 v0 = r0 + acc[ai][bj][m][0], v1 = r1 + acc[ai][bj][m][1];
                    *(u32x4*)(XB + (size_t)row * DM + col) = pack8(v0, v1);
                    sq += (v0[0] * v0[0] + v0[1] * v0[1]) + (v0[2] * v0[2] + v0[3] * v0[3]) + (v1[0] * v1[0] + v1[1] * v1[1]) + (v1[2] * v1[2] + v1[3] * v1[3]); }
                sq = red_sum32(red_sum16(sq));
                if (fq == 0) atomicAdd(ss + row, sq);
            }
    }
};
struct EpiScaleBf16 {
    static constexpr bool PERM = true, AFTER_DRAIN = false;
    const float* ss; bf16_t* O;
    DI void operator()(const f32x4 (&acc)[2][2][4][2], const Unit& u, int wr, int wc, int fr, int fq) const {
#pragma unroll
        for (int ai = 0; ai < 2; ++ai)
#pragma unroll
            for (int m = 0; m < 4; ++m) {
                const int row = u.pm * 256 + ai * 128 + wr * 64 + m * 16 + fr; const float rs = rsqrtf(ss[row] * (1.f / DM) + EPS);
#pragma unroll
                for (int bj = 0; bj < 2; ++bj) { const int col = u.pn * 256 + bj * 128 + wc * 32 + 8 * fq;
                    *(u32x4*)(O + (size_t)row * DM + col) = pack8(acc[ai][bj][m][0] * rs, acc[ai][bj][m][1] * rs); }
            }
    }
};
DI f32x4 silu_mul(const f32x4& c, const f32x4& v) { f32x4 r;
#pragma unroll
    for (int e = 0; e < 4; ++e) r[e] = c[e] / (1.f + __expf(-c[e])) * v[e];
    return r; }
struct EpiUp {
    static constexpr bool PERM = true, AFTER_DRAIN = false;
    const float* ss3; const float* wconv; const float* bconv; bf16_t* Ab; float* gfirst; float* vfirst; float* glast;
    DI void operator()(const f32x4 (&acc)[2][2][4][2], const Unit& u, int wr, int wc, int fr, int fq) const {
        const int col0 = u.pn * 128 + wc * 32 + 8 * fq, lane = fr + 16 * fq;
        const int s1 = (lane & ~15) | ((lane - 1) & 15), s2 = (lane & ~15) | ((lane - 2) & 15);
        f32x4 w0[2], w1[2], w2[2], bc[2];
#pragma unroll
        for (int n = 0; n < 2; ++n) { w0[n] = *(const f32x4*)(wconv + col0 + 4 * n); w1[n] = *(const f32x4*)(wconv + DFF + col0 + 4 * n); w2[n] = *(const f32x4*)(wconv + 2 * DFF + col0 + 4 * n); bc[n] = *(const f32x4*)(bconv + col0 + 4 * n); }
#pragma unroll
        for (int ai = 0; ai < 2; ++ai) {
            const int blk = u.pm * 4 + ai * 2 + wr;
            f32x4 pR1[2], pR2[2];
#pragma unroll
            for (int n = 0; n < 2; ++n) { pR1[n] = (f32x4){0.f, 0.f, 0.f, 0.f}; pR2[n] = pR1[n]; }
#pragma unroll
            for (int m = 0; m < 4; ++m) {
                const int row = u.pm * 256 + ai * 128 + wr * 64 + m * 16 + fr; const float rs = rsqrtf(ss3[row] * (1.f / DM) + EPS);
                f32x4 a[2];
#pragma unroll
                for (int n = 0; n < 2; ++n) {
                    const f32x4 g = acc[ai][0][m][n] * rs, vv = acc[ai][1][m][n] * rs; f32x4 R1, R2;
#pragma unroll
                    for (int e = 0; e < 4; ++e) { R1[e] = dpp_mov<0x121>(g[e]); R2[e] = dpp_mov<0x122>(g[e]); }
                    const f32x4 p1 = fr >= 1 ? R1 : pR1[n], p2 = fr >= 2 ? R2 : pR2[n];
                    const f32x4 cv = p2 * w0[n] + p1 * w1[n] + g * w2[n] + bc[n];
                    a[n] = silu_mul(cv, vv);
                    pR1[n] = R1; pR2[n] = R2;
                    if (m == 0 && fr < 2) { *(f32x4*)(gfirst + ((size_t)blk * 2 + fr) * DFF + col0 + 4 * n) = g; *(f32x4*)(vfirst + ((size_t)blk * 2 + fr) * DFF + col0 + 4 * n) = vv; }
                    if (m == 3 && fr >= 14) *(f32x4*)(glast + ((size_t)blk * 2 + fr - 14) * DFF + col0 + 4 * n) = g;
                }
                if (!(m == 0 && fr < 2)) *(u32x4*)(Ab + (size_t)row * DFF + col0) = pack8(a[0], a[1]);
            }
        }
    }
};
struct EpiPartial {
    static constexpr bool PERM = true, AFTER_DRAIN = false;
    float* part;
    DI void operator()(const f32x4 (&acc)[2][2][4][2], const Unit& u, int wr, int wc, int fr, int fq) const {
#pragma unroll
        for (int ai = 0; ai < 2; ++ai)
#pragma unroll
            for (int m = 0; m < 4; ++m) {
                float* o = part + (size_t)(ai * 128 + wr * 64 + m * 16 + fr) * 256 + wc * 32 + 8 * fq;
#pragma unroll
                for (int bj = 0; bj < 2; ++bj) { *(f32x4*)(o + bj * 128) = acc[ai][bj][m][0]; *(f32x4*)(o + bj * 128 + 4) = acc[ai][bj][m][1]; }
            }
    }
};
struct OneUnit {
    int pm, pn;
    DI bool next(int i, Unit& u) const { if (i > 0) return false; u.pm = pm; u.pn = pn; return true; }
    DI void a_ready(const Unit&) const {}
    DI void done(const Unit&) const {}
};
struct EpiDown {
    static constexpr bool PERM = true, AFTER_DRAIN = false;
    const bf16_t* X2B; float* out;
    DI void operator()(const f32x4 (&acc)[2][2][4][2], const Unit& u, int wr, int wc, int fr, int fq) const {
#pragma unroll
        for (int ai = 0; ai < 2; ++ai)
#pragma unroll
            for (int m = 0; m < 4; ++m) {
                const int row = u.pm * 256 + ai * 128 + wr * 64 + m * 16 + fr;
#pragma unroll
                for (int bj = 0; bj < 2; ++bj) { const size_t off = (size_t)row * DM + u.pn * 256 + bj * 128 + wc * 32 + 8 * fq;
                    f32x4 r0, r1; bf8_to_f32(*(const u32x4*)(X2B + off), r0, r1);
                    *(f32x4*)(out + off) = r0 + acc[ai][bj][m][0]; *(f32x4*)(out + off + 4) = r1 + acc[ai][bj][m][1]; }
                if (m & 1) __builtin_amdgcn_sched_barrier(0);
            }
    }
};

DI void cumsum_bh(const Params& p, LAS unsigned char* lds, int tid, int idx) {
    LAS float* wsum = (LAS float*)lds;
    const int beta = idx >> 3, h = idx & 7, lane = tid & 63, w = tid >> 6;
    const bool sample = beta >= 8; const int b = sample ? beta - 8 : beta;
    const int per = sample ? 9 : 8, T = sample ? 4160 : 4096;
    const float* lf_new = sample ? p.out + OFF_BL_S + (size_t)b * 64 * 8 : p.out + OFF_BL_P + (size_t)b * 4096 * 8;
    const float* lf_cache = p.in[6] + (size_t)b * 4096 * 8;
    float* dst = sample ? (float*)(p.ws + WS_CUMS) + ((size_t)b * 8 + h) * 4160 : (float*)(p.ws + WS_CUMP) + ((size_t)b * 8 + h) * 4096;
    float v[9];
#pragma unroll
    for (int i = 0; i < 9; ++i) { const int t = tid * per + i; float x = 0.f;
        if (i < per && t < T) x = sample ? (t < 4096 ? lf_cache[(size_t)t * 8 + h] : lf_new[(size_t)(t - 4096) * 8 + h]) : lf_new[(size_t)t * 8 + h];
        v[i] = x; }
    float s = 0.f;
#pragma unroll
    for (int i = 0; i < 9; ++i) { s += v[i]; v[i] = s; }
    float incl = s;
#pragma unroll
    for (int off = 1; off < 64; off <<= 1) { const float y = lane_read(incl, (lane - off) & 63); if (lane >= off) incl += y; }
    if (lane == 63) wsum[w] = incl;
    __syncthreads();
    float base = 0.f;
#pragma unroll
    for (int j = 0; j < 8; ++j) if (j < w) base += wsum[j];
    const float excl = base + incl - s;
#pragma unroll
    for (int i = 0; i < 9; ++i) { const int t = tid * per + i; if (i < per && t < T) dst[t] = excl + v[i]; }
    __syncthreads();
}

struct AttnArgs {
    const bf16_t* Q; int qstride; int nq; int qpos0; int kt_lo, kt_hi;
    const float* k32; const float* v32; int stride32; int n32;
    const bf16_t* k16; const bf16_t* v16; int stride16;
    bf16_t* O; int ostride;
    const float* cum; const float* tab; const float* gq; const float* gk;
};
DI f32x16 mfma32(bf16x8 a, bf16x8 b, f32x16 c) { return __builtin_amdgcn_mfma_f32_32x32x16_bf16(a, b, c, 0, 0, 0); }
typedef short v4i16_t __attribute__((ext_vector_type(4)));
DI s16x4 vtr(const LAS unsigned char* p) { return __builtin_bit_cast(s16x4, __builtin_amdgcn_ds_read_tr16_b64_v4i16((LAS v4i16_t*)p)); }

template <int D, int MODE, bool F32, int DV, int EXP = 0>
DI void attn_unit(LAS unsigned char* lds, const AttnArgs& a, int tid, int vcol0) {
    constexpr int KSTR = D * 2 + 16, TILE = 64 * KSTR, NCH = D / 8, PER = (64 * NCH) / 512;
    constexpr int VSTR = DV == 64 ? 192 : 288, VTILE = 64 * VSTR, NCHV = DV / 8, PERV = (64 * NCHV) / 512, BUFB = TILE + VTILE;
    constexpr int CUM_OFF = 2 * BUFB, TAB_OFF = CUM_OFF + 512;
    const int lane = tid & 63, w = __builtin_amdgcn_readfirstlane(tid >> 6), r = lane & 31, h = lane >> 5;
    const bool wact = 32 * w < a.nq;
    const int qrow = 32 * w + r, qpos = a.qpos0 + qrow, qw0 = a.qpos0 + 32 * w;
    int w_lo, w_hi;
    if (MODE == 0) { const int c = qw0 >> 6; w_lo = c - 8 < 0 ? 0 : c - 8; w_hi = c; }
    else if (MODE == 1) { w_lo = 0; w_hi = qw0 >> 6; }
    else { w_lo = a.kt_lo; w_hi = a.kt_hi; }
    if (!wact) { w_lo = 1; w_hi = 0; }
    bf16x8 qf[D / 16];
    {
        const bf16_t* qp = a.Q + (size_t)(wact ? qrow : 0) * a.qstride + 8 * h;
#pragma unroll
        for (int kk = 0; kk < D / 16; ++kk) qf[kk] = *(const bf16x8*)(qp + 16 * kk);
    }
    float sc = 1.f;
    if (MODE == 2) {
        float ss = 0.f;
#pragma unroll
        for (int kk = 0; kk < D / 16; ++kk)
#pragma unroll
            for (int j = 0; j < 8; ++j) { const float f = bf2f((unsigned short)qf[kk][j]); ss += f * f; }
        ss = red_sum32(ss);
        sc = rsqrtf(ss * (1.f / 256.f) + EPS) * 0.0625f * LOG2E;
    }
    float cref = 0.f;
    if (MODE == 1) cref = a.cum[a.qpos0];
    float sinit = 0.f;
    if (MODE != 2) {
        float gm = wave_max(fabsf(a.gq[lane])) * wave_max(fabsf(a.gk[lane])) * 8.f * LOG2E;
        if (MODE == 0) { float tm = fabsf(a.tab[lane]); tm = fmaxf(tm, fabsf(a.tab[lane + 64])); tm = fmaxf(tm, fabsf(a.tab[lane + 128])); tm = fmaxf(tm, fabsf(a.tab[lane + 192])); tm = fmaxf(tm, fabsf(a.tab[256])); gm += wave_max(tm) * LOG2E; }
        sinit = -gm;
        if (MODE == 1) sinit += (a.cum[wact ? qpos : a.qpos0] - cref) * LOG2E;
    }
    LAS float* tabl = (LAS float*)(lds + TAB_OFF);
    if (MODE == 0) { if (tid < 257) { const int rel = 192 - tid; tabl[tid] = a.tab[(rel > 128 ? 128 : rel) + 128] * LOG2E; } }
    f32x16 o[DV / 32];
#pragma unroll
    for (int n = 0; n < DV / 32; ++n)
#pragma unroll
        for (int i = 0; i < 16; ++i) o[n][i] = 0.f;
    float mrun = -1e30f, lrun = 0.f;

    u32x4 kr[2][PER], vr[2][PERV]; f32x4 kr2[2], vr2[2], kr3[2], vr3[2]; bool was32[2] = {false, false}; float cumr[2] = {0.f, 0.f};
#pragma unroll
    for (int i_ = 0; i_ < 2; ++i_) { kr2[i_] = (f32x4){0.f, 0.f, 0.f, 0.f}; vr2[i_] = kr2[i_]; kr3[i_] = kr2[i_]; vr3[i_] = kr2[i_]; }
    constexpr int RPK = 512 / NCH, RPV = 512 / NCHV;
    const unsigned voffK = (unsigned)((tid / NCH) * a.stride16 + 8 * (tid % NCH)) * 2u, voffV = (unsigned)((tid / NCHV) * a.stride16 + 8 * (tid % NCHV)) * 2u;
    const unsigned voff32 = (unsigned)((tid >> 3) * a.stride32 + 8 * (tid & 7)) * 4u;
    const unsigned ldsK = (unsigned)((tid / NCH) * KSTR + 16 * (tid % NCH)), ldsV = (unsigned)(TILE + (tid / NCHV) * VSTR + 16 * (tid % NCHV));
#define ISSUE(S, KT) do { const int kt_ = (KT); \
        if (F32 && kt_ < a.n32) { was32[S] = true; \
            const char* kb32_ = (const char*)a.k32 + (size_t)(64 * kt_) * a.stride32 * 4; const char* vb32_ = (const char*)a.v32 + (size_t)(64 * kt_) * a.stride32 * 4; \
            kr3[S] = __builtin_nontemporal_load((const f32x4*)(kb32_ + voff32)); kr2[S] = __builtin_nontemporal_load((const f32x4*)(kb32_ + voff32 + 16)); vr3[S] = __builtin_nontemporal_load((const f32x4*)(vb32_ + voff32)); vr2[S] = __builtin_nontemporal_load((const f32x4*)(vb32_ + voff32 + 16)); }     \
        else { was32[S] = false; \
            const char* kb16_ = (const char*)a.k16 + (size_t)(64 * (kt_ - a.n32)) * a.stride16 * 2; const char* vb16_ = (const char*)(a.v16 + vcol0) + (size_t)(64 * (kt_ - a.n32)) * a.stride16 * 2; \
            _Pragma("unroll") for (int j_ = 0; j_ < PER; ++j_) kr[S][j_] = *(const u32x4*)(kb16_ + (size_t)(j_ * RPK) * a.stride16 * 2 + voffK); \
            _Pragma("unroll") for (int j_ = 0; j_ < PERV; ++j_) vr[S][j_] = *(const u32x4*)(vb16_ + (size_t)(j_ * RPV) * a.stride16 * 2 + voffV); } \
        if (MODE == 1 && tid < 64) cumr[S] = a.cum[64 * kt_ + tid]; } while (0)
#define WRITE(S, BUF) do { LAS unsigned char* kb_ = lds + (BUF) * BUFB; \
        if (F32 && was32[S]) { *(LAS u32x4*)(kb_ + ldsK) = pack8(kr3[S], kr2[S]); *(LAS u32x4*)(kb_ + ldsV) = pack8(vr3[S], vr2[S]); } \
        else { _Pragma("unroll") for (int j_ = 0; j_ < PER; ++j_) *(LAS u32x4*)(kb_ + ldsK + j_ * RPK * KSTR) = kr[S][j_]; \
            _Pragma("unroll") for (int j_ = 0; j_ < PERV; ++j_) *(LAS u32x4*)(kb_ + ldsV + j_ * RPV * VSTR) = vr[S][j_]; } \
        if (MODE == 1 && tid < 64) ((LAS float*)(lds + CUM_OFF))[(BUF) * 64 + tid] = (cumr[S] - cref) * LOG2E; } while (0)

    const int rs23 = (r & ~12) | ((r & 4) << 1) | ((r & 8) >> 1);
    const int i16 = lane & 15, q_ = i16 >> 2, p_ = i16 & 3, g_ = (lane >> 4) & 1;
    constexpr int DIR = (MODE == 1) ? -1 : 1;
    const int kt_first = DIR > 0 ? a.kt_lo : a.kt_hi, ntiles = a.kt_hi - a.kt_lo + 1;
    ISSUE(0, kt_first); if (ntiles > 1) ISSUE(1, kt_first + DIR);
    WRITE(0, 0); __syncthreads();
    for (int it0 = 0; it0 < ntiles; it0 += 2) {
#pragma unroll
      for (int half = 0; half < 2; ++half) {
        const int it = it0 + half; if (it >= ntiles) break;
        const int kt = kt_first + DIR * it;
        const int buf = half;
        if (it + 2 < ntiles) ISSUE(half, kt + 2 * DIR);
        if (EXP != 4 && kt >= w_lo && kt <= w_hi) {
            const LAS unsigned char* Kt = lds + buf * BUFB; const LAS unsigned char* Vt = Kt + TILE;
            const LAS float* cl = (const LAS float*)(lds + CUM_OFF) + buf * 64;
#pragma unroll
            for (int stp = 0; stp < 2; ++stp) {
                const int step = DIR > 0 ? stp : 1 - stp;
                const int kpos0 = 64 * kt + 32 * step;
                if (MODE == 1 && kpos0 > qw0) continue;
                f32x16 s;
                const bool farb = (MODE == 0) && (qw0 - (kpos0 + 31) >= 128);
                const float s0v = farb ? sinit + tabl[0] : sinit;
#pragma unroll
                for (int i = 0; i < 16; ++i) s[i] = (MODE == 2) ? 0.f : s0v;
                const LAS unsigned char* kp = Kt + (32 * step + rs23) * KSTR + 16 * h;
                const LAS unsigned char* vb = Vt + (32 * step + 8 * h + q_) * VSTR + 32 * g_ + 8 * p_;
                bf16x8 kf[D / 16]; s16x4 vlo[DV / 32][2], vhi[DV / 32][2];
#pragma unroll
                for (int kk = 0; kk < D / 16; ++kk) kf[kk] = *(const LAS bf16x8*)(kp + 32 * kk);
#pragma unroll
                for (int n = 0; n < DV / 32; ++n) { vlo[n][0] = vtr(vb + 64 * n); vhi[n][0] = vtr(vb + 4 * VSTR + 64 * n); vlo[n][1] = vtr(vb + 16 * VSTR + 64 * n); vhi[n][1] = vtr(vb + 20 * VSTR + 64 * n); }
                __builtin_amdgcn_sched_barrier(0);
#pragma unroll
                for (int kk = 0; kk < D / 16; ++kk) { if (EXP == 3) { s[kk] += bf2f((unsigned short)kf[kk][0]) + bf2f((unsigned short)kf[kk][3]); } else s = mfma32(kf[kk], qf[kk], s); }
                if (MODE == 0) {
                    if (!farb) {
                        { const LAS float* tb = tabl + (192 - qpos + kpos0 + 8 * h);
#pragma unroll
                        for (int i = 0; i < 16; ++i) s[i] += tb[16 * (i >> 3) + (i & 7)]; } }
                } else if (MODE == 1) {
                    const LAS f32x4* c4 = (const LAS f32x4*)(cl + 32 * step + 8 * h);
                    const f32x4 c0 = c4[0], c1 = c4[1], c2 = c4[4], c3 = c4[5];
#pragma unroll
                    for (int e = 0; e < 4; ++e) { s[e] -= c0[e]; s[4 + e] -= c1[e]; s[8 + e] -= c2[e]; s[12 + e] -= c3[e]; }
                    if (kpos0 == qw0) {
#pragma unroll
                        for (int i = 0; i < 16; ++i) if (16 * (i >> 3) + 8 * h + (i & 7) > r) s[i] = -1e30f; }
                } else {
#pragma unroll
                    for (int i = 0; i < 16; ++i) s[i] *= sc;
                }
                if (MODE == 2) {
                float mx = s[0];
#pragma unroll
                for (int i = 1; i < 16; ++i) mx = fmaxf(mx, s[i]);
                mx = red_max32(mx);
                if (__builtin_amdgcn_ballot_w64(mx > mrun) != 0ull) {
                    const float mnew = fmaxf(mrun, mx), alpha = __builtin_amdgcn_exp2f(mrun - mnew); mrun = mnew; lrun *= alpha;
#pragma unroll
                    for (int n = 0; n < DV / 32; ++n)
#pragma unroll
                        for (int i = 0; i < 16; ++i) o[n][i] *= alpha;
                }
                float psum = 0.f;
#pragma unroll
                for (int i = 0; i < 16; ++i) { s[i] = __builtin_amdgcn_exp2f(s[i] - mrun); psum += s[i]; }
                lrun += psum;
                } else {
                float psum = 0.f;
#pragma unroll
                for (int i = 0; i < 16; ++i) { s[i] = __builtin_amdgcn_exp2f(s[i]); psum += s[i]; }
                lrun += psum;
                }
                u32x4 pw0, pw1;
                pw0.x = pk2(s[0], s[1]); pw0.y = pk2(s[2], s[3]); pw0.z = pk2(s[4], s[5]); pw0.w = pk2(s[6], s[7]);
                pw1.x = pk2(s[8], s[9]); pw1.y = pk2(s[10], s[11]); pw1.z = pk2(s[12], s[13]); pw1.w = pk2(s[14], s[15]);
                const bf16x8 pf0 = __builtin_bit_cast(bf16x8, pw0), pf1 = __builtin_bit_cast(bf16x8, pw1);
#pragma unroll
                for (int n = 0; n < DV / 32; ++n) {
                    { const bf16x8 vf = __builtin_shufflevector(vlo[n][0], vhi[n][0], 0, 1, 2, 3, 4, 5, 6, 7); if (EXP == 3) o[n][0] += bf2f((unsigned short)vf[0]) * bf2f((unsigned short)pf0[n]); else o[n] = mfma32(vf, pf0, o[n]); }
                    { const bf16x8 vf = __builtin_shufflevector(vlo[n][1], vhi[n][1], 0, 1, 2, 3, 4, 5, 6, 7); if (EXP == 3) o[n][1] += bf2f((unsigned short)vf[1]) * bf2f((unsigned short)pf1[n]); else o[n] = mfma32(vf, pf1, o[n]); }
                }
            }
        }
        if (it + 1 < ntiles) WRITE(half ^ 1, buf ^ 1);
        __syncthreads();
      }
    }
#undef ISSUE
#undef WRITE
    if (wact) {
        const float lt = red_sum32(lrun), inv = 1.f / lt;
        bf16_t* op = a.O + vcol0 + (size_t)qrow * a.ostride + 4 * h;
#pragma unroll
        for (int n = 0; n < DV / 32; ++n)
#pragma unroll
            for (int i4 = 0; i4 < 4; ++i4) {
                const unsigned lo = pk2(o[n][4 * i4] * inv, o[n][4 * i4 + 1] * inv), hi = pk2(o[n][4 * i4 + 2] * inv, o[n][4 * i4 + 3] * inv);
                *(unsigned long long*)(op + 32 * n + 8 * i4) = (unsigned long long)lo | ((unsigned long long)hi << 32);
            }
    }
}

DI void memnorm_rows(const Params& p, int item, int tid) {
    const int lane = tid & 63, wave = tid >> 6;
    const float* raw = (const float*)(p.ws + WS_MEMRAW);
    bf16_t* MK = (bf16_t*)(p.ws + WS_MK); bf16_t* MV = (bf16_t*)(p.ws + WS_MV);
    const f32x4 gk = ((const f32x4*)p.in[25])[lane], gq = ((const f32x4*)p.in[24])[lane];
    for (int i = 0; i < 4; ++i) {
        const int row = item * 32 + wave * 4 + i; const float* rr = raw + (size_t)row * 2048;
#pragma unroll
        for (int hm = 0; hm < 4; ++hm) {
            f32x4 v = ((const f32x4*)(rr + hm * 256))[lane];
            float ss = (v[0] * v[0] + v[1] * v[1]) + (v[2] * v[2] + v[3] * v[3]); ss = wave_sum(ss);
            const float rs = rsqrtf(ss * (1.f / 256.f) + EPS);
            v = v * rs * gk;
            ((f32x4*)(p.out + OFF_MK_P + (size_t)row * 1024 + hm * 256))[lane] = v;
            const f32x4 vq = v * gq;
            ((unsigned long long*)(MK + (size_t)row * 1024 + hm * 256))[lane] = (unsigned long long)pk2(vq[0], vq[1]) | ((unsigned long long)pk2(vq[2], vq[3]) << 32);
            const f32x4 vv = ((const f32x4*)(rr + 1024 + hm * 256))[lane];
            ((f32x4*)(p.out + OFF_MV_P + (size_t)row * 1024 + hm * 256))[lane] = vv;
            ((unsigned long long*)(MV + (size_t)row * 1024 + hm * 256))[lane] = (unsigned long long)pk2(vv[0], vv[1]) | ((unsigned long long)pk2(vv[2], vv[3]) << 32);
        }
    }
}

DI void gbar(unsigned* ctr, unsigned target, int tid) {
    asm volatile("s_waitcnt vmcnt(0)" ::: "memory");
    __syncthreads();
    if (tid == 0) {
        __builtin_amdgcn_fence(__ATOMIC_RELEASE, "agent");
        asm volatile("s_waitcnt vmcnt(0)" ::: "memory");
        __hip_atomic_fetch_add(ctr, 1u, __ATOMIC_RELAXED, __HIP_MEMORY_SCOPE_AGENT);
        while (__hip_atomic_load(ctr, __ATOMIC_RELAXED, __HIP_MEMORY_SCOPE_AGENT) < target) __builtin_amdgcn_s_sleep(1);
        __builtin_amdgcn_fence(__ATOMIC_ACQUIRE, "agent");
        asm volatile("s_waitcnt vmcnt(0)" ::: "memory");
    }
    __syncthreads();
}

DI int next_unit(LAS unsigned char* lds, unsigned* ctr, int tid) {
    LAS unsigned* nw = (LAS unsigned*)(lds + LDS_NEXT);
    if (tid == 0) *nw = atomicAdd(ctr, 1u);
    __syncthreads();
    const int u = (int)*nw;
    __syncthreads();
    return u;
}

template <int EXP>
DI void p2_attention(const Params& p, LAS unsigned char* lds, int tid) {
    unsigned* ctr = (unsigned*)(p.ws + WS_CTR) + (EXP ? 8 : 0);
    const bf16_t* P = (const bf16_t*)(p.ws + WS_P); bf16_t* Ob = (bf16_t*)(p.ws + (EXP ? WS_XB : WS_O));
    for (;;) {
        const int u = next_unit(lds, ctr, tid);
        if (u >= 2368) break;
        AttnArgs a; a.qstride = NQKV; a.stride16 = NQKV; a.ostride = DM; a.stride32 = 512; a.n32 = 0; a.k32 = nullptr; a.v32 = nullptr; a.cum = nullptr; a.tab = nullptr; a.gq = nullptr; a.gk = nullptr;
        if (u < 128) { const int b = u >> 3, h = u & 7; const size_t r0 = (size_t)(NP + 64 * b);
            a.Q = P + r0 * NQKV + 1536 + 64 * h; a.nq = 64; a.qpos0 = 4096; a.kt_lo = 0; a.kt_hi = 64; a.n32 = 64;
            a.k32 = p.in[4] + (size_t)b * 4096 * 512 + 64 * h; a.v32 = p.in[5] + (size_t)b * 4096 * 512 + 64 * h;
            a.k16 = P + r0 * NQKV + 2048 + 64 * h; a.v16 = P + r0 * NQKV + 2560 + 64 * h; a.O = Ob + r0 * DM + 512 + 64 * h;
            a.cum = (const float*)(p.ws + WS_CUMS) + ((size_t)b * 8 + h) * 4160; a.gq = p.in[16]; a.gk = p.in[17];
            attn_unit<64, 1, true, 64, EXP>(lds, a, tid, 0);
        } else if (u < 1152) { const int v = u - 128, g = 15 - (v >> 6), b = (v & 63) >> 3, h = v & 7; const size_t r0 = (size_t)b * 4096;
            a.Q = P + (r0 + 256 * g) * NQKV + 1536 + 64 * h; a.nq = 256; a.qpos0 = 256 * g; a.kt_lo = 0; a.kt_hi = 4 * g + 3;
            a.k16 = P + r0 * NQKV + 2048 + 64 * h; a.v16 = P + r0 * NQKV + 2560 + 64 * h; a.O = Ob + (r0 + 256 * g) * DM + 512 + 64 * h;
            a.cum = (const float*)(p.ws + WS_CUMP) + ((size_t)b * 8 + h) * 4096; a.gq = p.in[16]; a.gk = p.in[17];
            attn_unit<64, 1, false, 64, EXP>(lds, a, tid, 0);
        } else if (u < 2176) { const int v = u - 1152, g = v >> 6, b = (v & 63) >> 3, h = v & 7; const size_t r0 = (size_t)b * 4096;
            a.Q = P + (r0 + 256 * g) * NQKV + 64 * h; a.nq = 256; a.qpos0 = 256 * g; a.kt_lo = 4 * g - 8 < 0 ? 0 : 4 * g - 8; a.kt_hi = 4 * g + 3;
            a.k16 = P + r0 * NQKV + 512 + 64 * h; a.v16 = P + r0 * NQKV + 1024 + 64 * h; a.O = Ob + (r0 + 256 * g) * DM + 64 * h;
            a.tab = p.in[15] + h * 257; a.gq = p.in[13]; a.gk = p.in[14];
            attn_unit<64, 0, false, 64, EXP>(lds, a, tid, 0);
        } else if (u < 2304) { const int v = u - 2176, b = v >> 3, h = v & 7; const size_t r0 = (size_t)(NP + 64 * b);
            a.Q = P + r0 * NQKV + 64 * h; a.nq = 64; a.qpos0 = 512; a.kt_lo = 0; a.kt_hi = 8; a.n32 = 8;
            a.k32 = p.in[2] + (size_t)b * 512 * 512 + 64 * h; a.v32 = p.in[3] + (size_t)b * 512 * 512 + 64 * h;
            a.k16 = P + r0 * NQKV + 512 + 64 * h; a.v16 = P + r0 * NQKV + 1024 + 64 * h; a.O = Ob + r0 * DM + 64 * h;
            a.tab = p.in[15] + h * 257; a.gq = p.in[13]; a.gk = p.in[14];
            attn_unit<64, 0, true, 64, EXP>(lds, a, tid, 0);
        } else {
            if (!EXP) memnorm_rows(p, u - 2304, tid);
        }
    }
}

DI f32x4 mfma16(bf16x8 a, bf16x8 b, f32x4 c) { return __builtin_amdgcn_mfma_f32_16x16x32_bf16(a, b, c, 0, 0, 0); }
DI void mem_attn_unit(LAS unsigned char* lds, const bf16_t* Q, const bf16_t* K, const bf16_t* V, bf16_t* O, int nq, int tid) {
    constexpr int KSTR = 560, TILE = 64 * KSTR, BUFB = 2 * TILE;
    const int lane = tid & 63, w = __builtin_amdgcn_readfirstlane(tid >> 6), col = lane & 15, quad = lane >> 4;
    const bool wact = 16 * w < nq;
    const int qrow = 16 * w + col;
    f32x4 o[16];
#pragma unroll
    for (int mb = 0; mb < 16; ++mb) o[mb] = (f32x4){0.f, 0.f, 0.f, 0.f};
    float mrun = -1e30f, lrun = 0.f;
    u32x4 kr[4], vr[4];
    const unsigned voff = (unsigned)((tid >> 5) * DM + 8 * (tid & 31)) * 2u, ldso = (unsigned)((tid >> 5) * KSTR + 16 * (tid & 31));
#define MISSUE(KT) do { const char* kb_ = (const char*)K + (size_t)(64 * (KT)) * DM * 2; const char* vb_ = (const char*)V + (size_t)(64 * (KT)) * DM * 2; \
        _Pragma("unroll") for (int j_ = 0; j_ < 4; ++j_) { kr[j_] = *(const u32x4*)(kb_ + (size_t)(16 * j_) * DM * 2 + voff); vr[j_] = *(const u32x4*)(vb_ + (size_t)(16 * j_) * DM * 2 + voff); } } while (0)
#define MWRITE(BUF) do { LAS unsigned char* b_ = lds + (BUF) * BUFB + ldso; \
        _Pragma("unroll") for (int j_ = 0; j_ < 4; ++j_) { *(LAS u32x4*)(b_ + 16 * j_ * KSTR) = kr[j_]; *(LAS u32x4*)(b_ + TILE + 16 * j_ * KSTR) = vr[j_]; } } while (0)
    const int q_ = col >> 2, p_ = col & 3;
    MISSUE(0);
    bf16x8 qf[8];
    { const bf16_t* qp = Q + (size_t)(wact ? qrow : 0) * DM + 8 * quad;
#pragma unroll
      for (int kk = 0; kk < 8; ++kk) qf[kk] = *(const bf16x8*)(qp + 32 * kk); }
    float ss = 0.f;
#pragma unroll
    for (int kk = 0; kk < 8; ++kk)
#pragma unroll
        for (int j = 0; j < 8; ++j) { const float f = bf2f((unsigned short)qf[kk][j]); ss += f * f; }
    ss = red_sum32(red_sum16(ss));
    const float sc = rsqrtf(ss * (1.f / 256.f) + EPS) * 0.0625f * LOG2E;
    MWRITE(0); __syncthreads();
#pragma unroll 1
    for (int kt = 0; kt < 4; ++kt) {
        const int buf = kt & 1; const bool more = kt < 3;
        if (more) MISSUE(kt + 1);
        if (wact) {
            const LAS unsigned char* Kt = lds + buf * BUFB; const LAS unsigned char* Vt = Kt + TILE;
#pragma unroll
            for (int step = 0; step < 2; ++step) {
                f32x4 s0 = {0.f, 0.f, 0.f, 0.f}, s1 = s0;
                const LAS unsigned char* kp = Kt + (32 * step + col) * KSTR + 16 * quad;
#pragma unroll
                for (int kk = 0; kk < 8; ++kk) { const bf16x8 k0 = *(const LAS bf16x8*)(kp + 64 * kk), k1 = *(const LAS bf16x8*)(kp + 16 * KSTR + 64 * kk);
                    s0 = mfma16(k0, qf[kk], s0); s1 = mfma16(k1, qf[kk], s1); }
                s0 = s0 * sc; s1 = s1 * sc;
                float mx = fmaxf(fmaxf(fmaxf(s0[0], s0[1]), fmaxf(s0[2], s0[3])), fmaxf(fmaxf(s1[0], s1[1]), fmaxf(s1[2], s1[3])));
                mx = red_max32(red_max16(mx));
                const float mnew = fmaxf(mrun, mx), alpha = __builtin_amdgcn_exp2f(mrun - mnew); mrun = mnew;
                float psum = 0.f;
#pragma unroll
                for (int i = 0; i < 4; ++i) { s0[i] = __builtin_amdgcn_exp2f(s0[i] - mnew); s1[i] = __builtin_amdgcn_exp2f(s1[i] - mnew); psum += s0[i] + s1[i]; }
                lrun = lrun * alpha + psum;
#pragma unroll
                for (int mb = 0; mb < 16; ++mb) o[mb] = o[mb] * alpha;
                u32x4 pw; pw.x = pk2(s0[0], s0[1]); pw.y = pk2(s0[2], s0[3]); pw.z = pk2(s1[0], s1[1]); pw.w = pk2(s1[2], s1[3]);
                const bf16x8 pf = __builtin_bit_cast(bf16x8, pw);
                const LAS unsigned char* vb = Vt + (32 * step + 4 * quad + q_) * KSTR + 8 * p_;
#pragma unroll
                for (int mb = 0; mb < 16; ++mb) { const s16x4 lo = vtr(vb + 32 * mb), hi = vtr(vb + 16 * KSTR + 32 * mb);
                    const bf16x8 vf = __builtin_shufflevector(lo, hi, 0, 1, 2, 3, 4, 5, 6, 7); o[mb] = mfma16(vf, pf, o[mb]); }
            }
        }
        if (more) MWRITE(buf ^ 1);
        __syncthreads();
    }
#undef MISSUE
#undef MWRITE
    if (wact) {
        const float lt = red_sum32(red_sum16(lrun));
        const float inv = 1.f / lt;
        bf16_t* op = O + (size_t)qrow * DM + 4 * quad;
#pragma unroll
        for (int mb = 0; mb < 16; ++mb)
            *(unsigned long long*)(op + 16 * mb) = (unsigned long long)pk2(o[mb][0] * inv, o[mb][1] * inv) | ((unsigned long long)pk2(o[mb][2] * inv, o[mb][3] * inv) << 32);
    }
}

DI void p5_mem_attention(const Params& p, LAS unsigned char* lds, int tid) {
    const bf16_t* QM = (const bf16_t*)(p.ws + WS_QM); bf16_t* OM = (bf16_t*)(p.ws + WS_OM);
    const bf16_t* MK = (const bf16_t*)(p.ws + WS_MK); const bf16_t* MV = (const bf16_t*)(p.ws + WS_MV);
    for (int u = (int)blockIdx.x; u < 1088; u += (int)gridDim.x) {
        size_t r0; int kvb, hm, nq;
        if (u < 1024) { const int g = u & 31, b = u >> 7; hm = (u >> 5) & 3; r0 = (size_t)b * 4096 + 128 * g; kvb = b; nq = 128; }
        else { const int v = u - 1024, b = v >> 2; hm = v & 3; r0 = (size_t)(NP + 64 * b); kvb = 8 + b; nq = 64; }
        mem_attn_unit(lds, QM + r0 * DM + 256 * hm, MK + (size_t)kvb * 256 * 1024 + 256 * hm, MV + (size_t)kvb * 256 * 1024 + 256 * hm, OM + r0 * DM + 256 * hm, nq, tid);
    }
}

DI void p8_fixup(const Params& p, int tid) {
    const int gt = blockIdx.x * 512 + tid, NGT = gridDim.x * 512;
    const float* gfirst = (const float*)(p.ws + WS_SIDE); const float* vfirst = gfirst + SIDE_ELEMS; const float* glast = vfirst + SIDE_ELEMS;
    bf16_t* Ab = (bf16_t*)(p.ws + WS_AB);
    const float* wconv = p.in[29]; const float* bconv = p.in[30]; const float* st = p.in[9];
    constexpr int C4 = DFF / 4;
    for (int idx = gt; idx < 528 * 2 * C4; idx += NGT) {
        const int c4 = idx % C4, bj = idx / C4, j = bj & 1, blk = bj >> 1, col = 4 * c4;
        const bool start = blk >= 512 || (blk & 63) == 0;
        f32x4 pa, pb;
        if (start) { if (blk >= 512) { const float* s = st + (size_t)(blk - 512) * 2 * DFF + col; pa = *(const f32x4*)s; pb = *(const f32x4*)(s + DFF); } else { pa = (f32x4){0.f, 0.f, 0.f, 0.f}; pb = pa; } }
        else { const float* s = glast + (size_t)(blk - 1) * 2 * DFF + col; pa = *(const f32x4*)s; pb = *(const f32x4*)(s + DFF); }
        const f32x4 g0 = *(const f32x4*)(gfirst + (size_t)blk * 2 * DFF + col), g1 = *(const f32x4*)(gfirst + ((size_t)blk * 2 + 1) * DFF + col);
        const f32x4 gm2 = j == 0 ? pa : pb, gm1 = j == 0 ? pb : g0, gc = j == 0 ? g0 : g1;
        const f32x4 vv = *(const f32x4*)(vfirst + ((size_t)blk * 2 + j) * DFF + col);
        const f32x4 cv = gm2 * *(const f32x4*)(wconv + col) + gm1 * *(const f32x4*)(wconv + DFF + col) + gc * *(const f32x4*)(wconv + 2 * DFF + col) + *(const f32x4*)(bconv + col);
        const f32x4 a = silu_mul(cv, vv);
        *(unsigned long long*)(Ab + (size_t)(blk * 64 + j) * DFF + col) = (unsigned long long)pk2(a[0], a[1]) | ((unsigned long long)pk2(a[2], a[3]) << 32);
    }
    for (int idx = gt; idx < 24 * 2 * C4; idx += NGT) {
        const int c4 = idx % C4, bj = idx / C4, j = bj & 1, b = bj >> 1, col = 4 * c4;
        const int blk = b < 8 ? 64 * b + 63 : 512 + (b - 8);
        const f32x4 g = *(const f32x4*)(glast + ((size_t)blk * 2 + j) * DFF + col);
        float* dst = b < 8 ? p.out + OFF_CV_P + ((size_t)b * 2 + j) * DFF + col : p.out + OFF_CV_S + ((size_t)(b - 8) * 2 + j) * DFF + col;
        *(f32x4*)dst = g;
    }
}


template <int NSPLIT, class Fin>
DI void splitk_tail(LAS unsigned char* lds, const bf16_t* A, const bf16_t* Bt, int Kpitch, int ntp, float* parts_base, unsigned* cnt_base, const Fin& fin, int wave_s) {
    if ((int)blockIdx.x >= 16 * NSPLIT) return;
    const int pc = (int)blockIdx.x, un = pc / NSPLIT, ks = pc % NSPLIT;
    float* parts = parts_base + (size_t)un * NSPLIT * 65536;
    pg8::Gemm g2{A + 64 * ntp * ks, Bt + 64 * ntp * ks, MT, 1024, Kpitch, ntp};
    OneUnit S2{128 + (un >> 2), un & 3};
    EpiPartial E2{parts + (size_t)ks * 65536};
    pg8::gemm_phase<EpiPartial, OneUnit, true, true>(lds, g2, S2, E2, fresh_tid(wave_s));
    gbar(cnt_base + un, (unsigned)NSPLIT, fresh_tid(wave_s));
    constexpr int RP = (256 + NSPLIT - 1) / NSPLIT, NJ = RP * 64 / 512;
    const int t = fresh_tid(wave_s), r0 = ks * RP;
#pragma unroll
    for (int j = 0; j < NJ; ++j) { const int e = t + 512 * j, rr = r0 + (e >> 6), c4 = (e & 63) * 4;
        if (rr < 256) { f32x4 acc_ = {0.f, 0.f, 0.f, 0.f};
#pragma unroll
            for (int q = 0; q < NSPLIT; ++q) acc_ += *(const f32x4*)(parts + (size_t)q * 65536 + rr * 256 + c4);
            fin((128 + (un >> 2)) * 256 + rr, (un & 3) * 256 + c4, acc_, t & 63); } }
}
DI f32x4 bf4_to_f32(unsigned long long w) { f32x4 a; const unsigned lo = (unsigned)w, hi = (unsigned)(w >> 32);
    a[0] = __uint_as_float(lo << 16); a[1] = __uint_as_float(lo & 0xffff0000u); a[2] = __uint_as_float(hi << 16); a[3] = __uint_as_float(hi & 0xffff0000u); return a; }
template <bool SRC16>
struct FinRes {
    const float* src; const bf16_t* src16; bf16_t* XB; float* ss;
    DI void operator()(int row, int col, const f32x4& a, int lane) const {
        f32x4 r;
        if (SRC16) r = bf4_to_f32(*(const unsigned long long*)(src16 + (size_t)row * DM + col)); else r = *(const f32x4*)(src + (size_t)(row - NP) * DM + col);
        const f32x4 v = r + a;
        *(unsigned long long*)(XB + (size_t)row * DM + col) = (unsigned long long)pk2(v[0], v[1]) | ((unsigned long long)pk2(v[2], v[3]) << 32);
        float sq = (v[0] * v[0] + v[1] * v[1]) + (v[2] * v[2] + v[3] * v[3]); sq = wave_sum(sq);
        if (lane == 0) atomicAdd(ss + row, sq);
    }
};
struct FinScale {
    const float* ss; bf16_t* O;
    DI void operator()(int row, int col, const f32x4& a, int) const {
        const float rs = rsqrtf(ss[row] * (1.f / DM) + EPS);
        *(unsigned long long*)(O + (size_t)row * DM + col) = (unsigned long long)pk2(a[0] * rs, a[1] * rs) | ((unsigned long long)pk2(a[2] * rs, a[3] * rs) << 32);
    }
};
struct FinDown {
    const bf16_t* X2B; float* out;
    DI void operator()(int row, int col, const f32x4& a, int) const { const size_t off = (size_t)row * DM + col;
        *(f32x4*)(out + off) = bf4_to_f32(*(const unsigned long long*)(X2B + off)) + a; }
};

__global__ void __launch_bounds__(512, 2) mega_fwd(Params p) {
    extern __shared__ __attribute__((aligned(16))) unsigned char lds_raw[];
    LAS unsigned char* lds = (LAS unsigned char*)lds_raw;
    const int wave_s = __builtin_amdgcn_readfirstlane((int)threadIdx.x >> 6), G = gridDim.x;
    unsigned char* ws = p.ws;
    unsigned* gctr = (unsigned*)(ws + WS_CTR) + 32; unsigned bar_k = 0;
#define TID() fresh_tid(wave_s)

#ifndef PM
#define PM 0x3ff
#endif
#ifndef PROBE_LO
#define PROBE_LO -1
#define PROBE_HI -1
#endif
#define STAMP(k) do { if (PROBE_LO >= 0 && blockIdx.x == 0 && TID() == 0) { unsigned long long* tsw = (unsigned long long*)(p.ws + WS_CTR + 1024); \
        if ((k) == PROBE_LO) tsw[0] = __builtin_amdgcn_s_memrealtime(); if ((k) == PROBE_HI + 1) tsw[1] = __builtin_amdgcn_s_memrealtime(); } } while (0)
    STAMP(0);
    if constexpr (PM & 1) p0_prologue(p, lds, TID());
    cg::this_grid().sync();
    STAMP(1);
    if constexpr ((PM >> 1) & 1) {
        pg8::Gemm g{(const bf16_t*)(ws + WS_XB), (const bf16_t*)(ws + WS_WIN), MA, 5120, 1024};
        DualOrder S; S.nM = 132; S.nN = 12; S.n1 = 132 * 12; S.G = G; S.c = (int)blockIdx.x; S.nM2 = 8; S.n2 = 64; S.pm_off = 132; S.pn_off = 12;
        EpiInProj E{(const float*)(ws + WS_RSTD1), (bf16_t*)(ws + WS_P), p.out, (float*)(ws + WS_MEMRAW), (const float*)(ws + WS_GTAB)};
        pg8::gemm_phase<EpiInProj, DualOrder, true, true>(lds, g, S, E, TID());
        if (blockIdx.x < 192) cumsum_bh(p, lds, TID(), (int)blockIdx.x);
    }
    gbar(gctr, (++bar_k) * (unsigned)G, TID());
    STAMP(2);
#ifdef P2EXP
    { if (blockIdx.x == 0 && TID() == 0) ((unsigned long long*)(p.ws + WS_CTR + 1024))[0] = __builtin_amdgcn_s_memrealtime();
      p2_attention<P2EXP>(p, lds, TID());
      gbar(gctr, (++bar_k) * (unsigned)G, TID());
      if (blockIdx.x == 0 && TID() == 0) ((unsigned long long*)(p.ws + WS_CTR + 1024))[1] = __builtin_amdgcn_s_memrealtime(); }
#endif
    if constexpr ((PM >> 2) & 1) p2_attention<0>(p, lds, TID());
    gbar(gctr, (++bar_k) * (unsigned)G, TID());
    STAMP(3);
    if constexpr ((PM >> 3) & 1) {
        pg8::Gemm g{(const bf16_t*)(ws + WS_O), (const bf16_t*)(ws + WS_WO), MT, 1024, 1024};
        pg8::StaticOrder S; S.init(MT, 1024, G, (int)blockIdx.x);
        EpiRes<true> E{nullptr, nullptr, (const bf16_t*)(ws + WS_XB), (bf16_t*)(ws + WS_X1B), (float*)(ws + WS_SS2)};
        pg8::gemm_phase<EpiRes<true>, pg8::StaticOrder, true, true>(lds, g, S, E, TID());
    }
    gbar(gctr, (++bar_k) * (unsigned)G, TID());
    STAMP(4);
    if constexpr ((PM >> 4) & 1) {
        pg8::Gemm g{(const bf16_t*)(ws + WS_X1B), (const bf16_t*)(ws + WS_WMQ), MT, 1024, 1024};
        pg8::StaticOrder S; S.init(MT, 1024, G, (int)blockIdx.x);
        EpiScaleBf16 E{(const float*)(ws + WS_SS2), (bf16_t*)(ws + WS_QM)};
        pg8::gemm_phase<EpiScaleBf16, pg8::StaticOrder, true, true>(lds, g, S, E, TID());
    }
    gbar(gctr, (++bar_k) * (unsigned)G, TID());
    STAMP(5);
    if constexpr ((PM >> 5) & 1) p5_mem_attention(p, lds, TID());
    gbar(gctr, (++bar_k) * (unsigned)G, TID());
    STAMP(6);
    if constexpr ((PM >> 6) & 1) {
        pg8::Gemm g{(const bf16_t*)(ws + WS_OM), (const bf16_t*)(ws + WS_WMO), MT, 1024, 1024};
        pg8::StaticOrder S; S.init(MT, 1024, G, (int)blockIdx.x);
        EpiRes<true> E{nullptr, nullptr, (const bf16_t*)(ws + WS_X1B), (bf16_t*)(ws + WS_X2B), (float*)(ws + WS_SS3)};
        pg8::gemm_phase<EpiRes<true>, pg8::StaticOrder, true, true>(lds, g, S, E, TID());
    }
    gbar(gctr, (++bar_k) * (unsigned)G, TID());
    STAMP(7);
    if constexpr ((PM >> 7) & 1) {
        pg8::Gemm g{(const bf16_t*)(ws + WS_X2B), (const bf16_t*)(ws + WS_WUP), MT, 2 * DFF, 1024};
        pg8::StaticOrder S; S.init(MT, 2 * DFF, G, (int)blockIdx.x);
        float* side = (float*)(ws + WS_SIDE);
        EpiUp E{(const float*)(ws + WS_SS3), p.in[29], p.in[30], (bf16_t*)(ws + WS_AB), side, side + SIDE_ELEMS, side + 2 * SIDE_ELEMS};
        pg8::gemm_phase<EpiUp, pg8::StaticOrder, true, true>(lds, g, S, E, TID());
    }
    gbar(gctr, (++bar_k) * (unsigned)G, TID());
    STAMP(8);
    if constexpr ((PM >> 8) & 1) p8_fixup(p, TID());
    gbar(gctr, (++bar_k) * (unsigned)G, TID());
    STAMP(9);
    if constexpr ((PM >> 9) & 1) {
        pg8::Gemm g{(const bf16_t*)(ws + WS_AB), (const bf16_t*)(ws + WS_WDN), NP, 1024, DFF};
        pg8::StaticOrder S; S.init(NP, 1024, G, (int)blockIdx.x);
        EpiDown E{(const bf16_t*)(ws + WS_X2B), p.out};
        pg8::gemm_phase<EpiDown, pg8::StaticOrder, true, true>(lds, g, S, E, TID());
        { FinDown F{(const bf16_t*)(ws + WS_X2B), p.out};
          splitk_tail<11>(lds, (const bf16_t*)(ws + WS_AB), (const bf16_t*)(ws + WS_WDN), DFF, 4, (float*)(ws + WS_SIDE), (unsigned*)(ws + WS_CTR) + 112, F, wave_s); }
    }
    if (PROBE_LO >= 0) { gbar(gctr, (++bar_k) * (unsigned)G, TID()); STAMP(10);
        if (blockIdx.x == 0 && TID() == 0) { volatile unsigned long long* tsw = (volatile unsigned long long*)(p.ws + WS_CTR + 1024); const unsigned long long te = __builtin_amdgcn_s_memrealtime(), d = 4ull * (tsw[1] - tsw[0]); while (__builtin_amdgcn_s_memrealtime() - te < d) __builtin_amdgcn_s_sleep(32); } }
}

extern "C" void kernel_launch(void* const* d_in, const int* in_sizes, int n_in, void* d_out, int out_size, void* d_ws, size_t ws_size, hipStream_t stream) {
    static int grid = 0;
    if (grid == 0) {
        if (n_in != 32 || (size_t)out_size != OUT_TOTAL || ws_size < WS_END) { fprintf(stderr, "kernel_launch: unexpected shapes: n_in %d out %d ws %zu\n", n_in, out_size, ws_size); grid = -1; return; }
        int dev = 0, cus = 0, per_cu = 0;
        hipGetDevice(&dev); hipDeviceGetAttribute(&cus, hipDeviceAttributeMultiprocessorCount, dev);
        if (hipFuncSetAttribute((const void*)mega_fwd, hipFuncAttributeMaxDynamicSharedMemorySize, LDS_BYTES) != hipSuccess) { fprintf(stderr, "kernel_launch: hipFuncSetAttribute failed\n"); grid = -1; return; }
        if (hipOccupancyMaxActiveBlocksPerMultiprocessor(&per_cu, (const void*)mega_fwd, 512, LDS_BYTES) != hipSuccess || per_cu < 1) { fprintf(stderr, "kernel_launch: occupancy query says %d\n", per_cu); per_cu = 1; }
        (void)hipGetLastError();
        grid = cus;
    }
    if (grid < 0) return;
    Params p{};
    for (int i = 0; i < 32; ++i) p.in[i] = (const float*)d_in[i];
    p.out = (float*)d_out; p.ws = (unsigned char*)d_ws;
    void* args[] = {&p};
    hipError_t e = hipLaunchCooperativeKernel((const void*)mega_fwd, dim3(grid), dim3(512), args, LDS_BYTES, stream);
    if (e != hipSuccess) fprintf(stderr, "cooperative launch failed: %s (grid %d)\n", hipGetErrorString(e), grid);
}
```

```cpp
#include <hip/hip_runtime.h>
#include <hip/hip_cooperative_groups.h>
#include <cstdio>
#include <cstdint>
namespace cg = cooperative_groups;
namespace pg8 {
#define PG8_LAS __attribute__((address_space(3)))
typedef unsigned short bf16_t;
typedef short bf16x8 __attribute__((ext_vector_type(8)));
typedef float f32x4 __attribute__((ext_vector_type(4)));
typedef unsigned u32x4 __attribute__((ext_vector_type(4)));
constexpr int BM = 256, BK = 64, HALF = 128, HTB = HALF * BK * 2  , STAGE_BYTES = 8 * HTB, NXCD = 8, WGM = 8;

__host__ __device__ __forceinline__ int lds_byte(int r, int c) { const int st = (r >> 4) * 2 + (c >> 5), rr = r & 15, cc = c & 31, ob = rr * 64 + cc * 2; return st * 1024 + (ob ^ (((ob >> 9) & 1) << 5)); }
__host__ __device__ __forceinline__ void stage_rc(int b, int& R, int& C) { const int st = b / 1024, sb = b % 1024, swz = sb ^ (((sb >> 9) & 1) << 5); R = (st >> 1) * 16 + swz / 64; C = (st & 1) * 32 + (swz % 64) / 2; }
__host__ __device__ __forceinline__ int perm32(int rho) { const int n = rho >> 4, i = rho & 15; return 8 * (i >> 2) + 4 * n + (i & 3); }

struct Unit { int pm, pn; };
struct Gemm { const bf16_t* A; const bf16_t* Bt; int M, N, K; int nt; };

struct StaticOrder {
    int nM, nN, nwg, G, c;
    __host__ __device__ void init(int M, int N, int G_, int c_) { nM = M / BM; nN = N / BM; nwg = nM * nN; G = G_; c = c_; }
    __host__ __device__ bool next(int i, Unit& u) const {
        const long L = (long)i * G + c; if (L >= nwg) return false;
        int wgid = (int)L; { const int q = nwg / NXCD, r = nwg % NXCD, xcd = wgid % NXCD, off = wgid / NXCD; wgid = (xcd < r ? xcd * (q + 1) : r * (q + 1) + (xcd - r) * q) + off; }
        const int nig = WGM * nN, gid = wgid / nig, fm = gid * WGM, gsz = (nM - fm) < WGM ? (nM - fm) : WGM;
        u.pm = fm + ((wgid % nig) % gsz); u.pn = (wgid % nig) / gsz; return true;
    }
    __device__ __forceinline__ void a_ready(const Unit&) const {}
    __device__ __forceinline__ void done(const Unit&) const {}
};

typedef float f32x2 __attribute__((ext_vector_type(2)));
__device__ __forceinline__ unsigned cvt_pk_bf16(float lo, float hi) { unsigned r; asm volatile("v_cvt_pk_bf16_f32 %0, %1, %2" : "=v"(r) : "v"(lo), "v"(hi)); return r; }
template <class Epi, class Sched, bool ALIGN_EPI = false, bool SP2 = false>
__device__ __forceinline__ void gemm_phase(PG8_LAS unsigned char* lds, const Gemm g, const Sched& S, const Epi& E, const int tid_in) {
    int tid_ = tid_in; asm volatile("" : "+v"(tid_));
    const int tid = tid_, wid = __builtin_amdgcn_readfirstlane(tid >> 6), lane = tid & 63, wr = wid >> 2, wc = wid & 3, fr = lane & 15, fq = lane >> 4;
    const int K = g.K, nt = g.nt > 0 ? g.nt : K / BK;
    unsigned voffA[2], voffB[2];
#pragma unroll
    for (int i = 0; i < 2; ++i) { int R, C; stage_rc(tid * 16 + i * 8192, R, C); const int Rb = Epi::PERM ? ((R & ~31) + perm32(R & 31)) : R;
        voffA[i] = (unsigned)(R * K + C) * 2u; voffB[i] = (unsigned)(Rb * K + C) * 2u; }
    const size_t kstep = (size_t)(BK * 2);
    const size_t hstep = (size_t)HALF * K * 2;
    const size_t tstep = 2 * hstep;
    const unsigned ldsw = (unsigned)wid * 1024u;
    const int aoff = lds_byte(wr * 64 + fr, fq * 8), boff = lds_byte(wc * 32 + fr, fq * 8);
#define PG8_SA(b, h) (((b) * 2 + (h)) * HTB)
#define PG8_SB(b, h) ((4 + (b) * 2 + (h)) * HTB)
#define PG8_STAGE(bufoff, gbase, voff) do { _Pragma("unroll") for (int _i = 0; _i < 2; ++_i) \
        __builtin_amdgcn_global_load_lds((const unsigned*)((const char*)(gbase) + (voff)[_i]), (PG8_LAS unsigned*)(lds + (bufoff) + ldsw + _i * 8192), 16, 0, 0); } while (0)
#define PG8_LDA(dst, b, h) do { _Pragma("unroll") for (int m = 0; m < 4; ++m) _Pragma("unroll") for (int k = 0; k < 2; ++k) dst[m][k] = *(const PG8_LAS bf16x8*)(lds + PG8_SA(b, h) + aoff + m * 2048 + k * 1024); } while (0)
#define PG8_LDB(dst, b, h) do { _Pragma("unroll") for (int n = 0; n < 2; ++n) _Pragma("unroll") for (int k = 0; k < 2; ++k) dst[n][k] = *(const PG8_LAS bf16x8*)(lds + PG8_SB(b, h) + boff + n * 2048 + k * 1024); } while (0)
#define PG8_MMA(ai, bj, At, Bt) do { __builtin_amdgcn_s_setprio(1); _Pragma("unroll") for (int m = 0; m < 4; ++m) _Pragma("unroll") for (int n = 0; n < 2; ++n) _Pragma("unroll") for (int k = 0; k < 2; ++k) \
        acc[ai][bj][m][n] = __builtin_amdgcn_mfma_f32_16x16x32_bf16(Bt[n][k], At[m][k], acc[ai][bj][m][n], 0, 0, 0); __builtin_amdgcn_s_setprio(0); } while (0)
#define PG8_WAIT_V(n) asm volatile("s_waitcnt vmcnt(" #n ")" ::: "memory")
#define PG8_WAIT_L(n) asm volatile("s_waitcnt lgkmcnt(" #n ")" ::: "memory")
#define PG8_BAR __builtin_amdgcn_s_barrier()
#define PG8_SCHED __builtin_amdgcn_sched_barrier(0)
    Unit cur, nxt; int ui = 0;
    if (!S.next(0, cur)) return;
    f32x4 acc[2][2][4][2];
#pragma unroll
    for (int a = 0; a < 2; ++a)
#pragma unroll
        for (int b = 0; b < 2; ++b)
#pragma unroll
            for (int m = 0; m < 4; ++m)
#pragma unroll
                for (int n = 0; n < 2; ++n) acc[a][b][m][n] = (f32x4){0.f, 0.f, 0.f, 0.f};
    bf16x8 At[4][2], B0[2][2], B1[2][2];
    const char* cA = (const char*)g.A + (size_t)cur.pm * tstep; const char* cB = (const char*)g.Bt + (size_t)cur.pn * tstep;
    S.a_ready(cur);
    if constexpr (SP2) {
        PG8_STAGE(PG8_SB(0, 0), cB, voffB); PG8_STAGE(PG8_SB(0, 1), cB + hstep, voffB); PG8_STAGE(PG8_SA(0, 0), cA, voffA); PG8_STAGE(PG8_SA(0, 1), cA + hstep, voffA);
        if (wr == 1) PG8_BAR;
        PG8_WAIT_V(2); PG8_BAR;
        PG8_STAGE(PG8_SB(1, 0), cB + kstep, voffB); PG8_STAGE(PG8_SA(1, 0), cA + kstep, voffA); PG8_STAGE(PG8_SB(1, 1), cB + hstep + kstep, voffB);
        PG8_WAIT_V(6); PG8_BAR;
    } else {
        PG8_STAGE(PG8_SB(0, 0), cB, voffB); PG8_STAGE(PG8_SA(0, 0), cA, voffA); PG8_STAGE(PG8_SB(0, 1), cB + hstep, voffB); PG8_STAGE(PG8_SA(0, 1), cA + hstep, voffA);
        if (wr == 1) PG8_BAR;
        PG8_WAIT_V(4); PG8_BAR;
        PG8_STAGE(PG8_SB(1, 0), cB + kstep, voffB); PG8_STAGE(PG8_SA(1, 0), cA + kstep, voffA); PG8_STAGE(PG8_SB(1, 1), cB + hstep + kstep, voffB);
        PG8_WAIT_V(6); PG8_BAR;
    }
    for (;;) {
        const bool has_next = S.next(ui + 1, nxt);
        const char* nA = has_next ? (const char*)g.A + (size_t)nxt.pm * tstep : cA; const char* nB = has_next ? (const char*)g.Bt + (size_t)nxt.pn * tstep : cB;
        for (int t = 0; t < nt; t += 2) {
            const bool last = (t == nt - 2);
            const char* a1 = cA + (size_t)(t + 1) * kstep;
            const char* a2 = last ? nA : cA + (size_t)(t + 2) * kstep; const char* b2 = last ? nB : cB + (size_t)(t + 2) * kstep;
            const char* a3 = a2 + kstep; const char* b3 = b2 + kstep;
            if (last && has_next) S.a_ready(nxt);
            if constexpr (SP2) {
            PG8_LDB(B0, 0, 0); PG8_LDB(B1, 0, 1); PG8_SCHED; PG8_LDA(At, 0, 0); PG8_STAGE(PG8_SA(1, 1), a1 + hstep, voffA);
            PG8_WAIT_V(8); PG8_WAIT_L(0); PG8_BAR; PG8_MMA(0, 0, At, B0); PG8_MMA(0, 1, At, B1); PG8_BAR; PG8_SCHED;
            PG8_LDA(At, 0, 1); PG8_STAGE(PG8_SB(0, 0), b2, voffB); PG8_STAGE(PG8_SB(0, 1), b2 + hstep, voffB); PG8_STAGE(PG8_SA(0, 0), a2, voffA);
            PG8_WAIT_V(8); PG8_WAIT_L(0); PG8_BAR; PG8_MMA(1, 0, At, B0); PG8_MMA(1, 1, At, B1); PG8_BAR; PG8_SCHED;
            PG8_LDB(B0, 1, 0); PG8_LDB(B1, 1, 1); PG8_SCHED; PG8_LDA(At, 1, 0); PG8_STAGE(PG8_SA(0, 1), a2 + hstep, voffA);
            PG8_WAIT_V(8); PG8_WAIT_L(0); PG8_BAR; PG8_MMA(0, 0, At, B0); PG8_MMA(0, 1, At, B1); PG8_BAR; PG8_SCHED;
            PG8_LDA(At, 1, 1); PG8_STAGE(PG8_SB(1, 0), b3, voffB); PG8_STAGE(PG8_SB(1, 1), b3 + hstep, voffB); PG8_STAGE(PG8_SA(1, 0), a3, voffA);
            PG8_WAIT_V(8); PG8_WAIT_L(0); PG8_BAR; PG8_MMA(1, 0, At, B0); PG8_MMA(1, 1, At, B1); PG8_BAR; PG8_SCHED;
            } else {
            PG8_LDB(B0, 0, 0); PG8_SCHED; PG8_LDA(At, 0, 0); PG8_STAGE(PG8_SA(1, 1), a1 + hstep, voffA);
            PG8_WAIT_L(8); PG8_BAR; PG8_WAIT_L(0); PG8_MMA(0, 0, At, B0); PG8_BAR; PG8_SCHED;
            PG8_LDB(B1, 0, 1); PG8_STAGE(PG8_SB(0, 0), b2, voffB);
            PG8_BAR; PG8_WAIT_L(0); PG8_MMA(0, 1, At, B1); PG8_BAR;
            PG8_LDA(At, 0, 1); PG8_STAGE(PG8_SA(0, 0), a2, voffA);
            PG8_BAR; PG8_WAIT_L(0); PG8_MMA(1, 0, At, B0); PG8_BAR; PG8_SCHED;
            PG8_STAGE(PG8_SB(0, 1), b2 + hstep, voffB);
            PG8_WAIT_V(6); PG8_BAR; PG8_MMA(1, 1, At, B1); PG8_BAR;
            PG8_LDB(B0, 1, 0); PG8_SCHED; PG8_LDA(At, 1, 0); PG8_STAGE(PG8_SA(0, 1), a2 + hstep, voffA);
            PG8_WAIT_L(8); PG8_BAR; PG8_WAIT_L(0); PG8_MMA(0, 0, At, B0); PG8_BAR; PG8_SCHED;
            PG8_LDB(B1, 1, 1); PG8_STAGE(PG8_SB(1, 0), b3, voffB);
            PG8_BAR; PG8_WAIT_L(0); PG8_MMA(0, 1, At, B1); PG8_BAR;
            PG8_LDA(At, 1, 1); PG8_STAGE(PG8_SA(1, 0), a3, voffA);
            PG8_BAR; PG8_WAIT_L(0); PG8_MMA(1, 0, At, B0); PG8_BAR; PG8_SCHED;
            PG8_STAGE(PG8_SB(1, 1), b3 + hstep, voffB);
            PG8_WAIT_V(6); PG8_BAR; PG8_MMA(1, 1, At, B1); PG8_BAR;
            }
        }
        if constexpr (ALIGN_EPI) { if (wr == 0) PG8_BAR; }
        if constexpr (!Epi::AFTER_DRAIN) { E(acc, cur, wr, wc, fr, fq); S.done(cur); }
        if (!has_next) break;
#pragma unroll
        for (int a = 0; a < 2; ++a)
#pragma unroll
            for (int b = 0; b < 2; ++b)
#pragma unroll
                for (int m = 0; m < 4; ++m)
#pragma unroll
                    for (int n = 0; n < 2; ++n) acc[a][b][m][n] = (f32x4){0.f, 0.f, 0.f, 0.f};
        cur = nxt; cA = nA; cB = nB; ++ui;
        if constexpr (ALIGN_EPI) { if (wr == 1) PG8_BAR; }
    }
    PG8_WAIT_V(0);
    if constexpr (!ALIGN_EPI) { if (wr == 0) PG8_BAR; }
    PG8_BAR;
    if constexpr (Epi::AFTER_DRAIN) { E.fused(acc, cur, wr, wc, fr, fq, lds, wid, lane); S.done(cur); }
#undef PG8_SA
#undef PG8_SB
#undef PG8_STAGE
#undef PG8_LDA
#undef PG8_LDB
#undef PG8_MMA
#undef PG8_WAIT_V
#undef PG8_WAIT_L
#undef PG8_BAR
#undef PG8_SCHED
}
}

#define LAS __attribute__((address_space(3)))
using pg8::bf16_t; using pg8::bf16x8; using pg8::f32x4; using pg8::u32x4; using pg8::Unit;
typedef float f32x16 __attribute__((ext_vector_type(16)));
typedef short s16x4 __attribute__((ext_vector_type(4)));
typedef float f32x2v __attribute__((ext_vector_type(2)));
typedef __bf16 bf16x2v __attribute__((ext_vector_type(2)));
#define DI __device__ __forceinline__
#define LDS_WAIT() asm volatile("s_waitcnt lgkmcnt(0)" ::: "memory")

constexpr int DM = 1024, NP = 32768, NS = 1024, MT = NP + NS, MEMR = 2048, MA = MT + MEMR, DFF = 2816, NQKV = 3072;
constexpr float EPS = 1e-6f, LOG2E = 1.44269504088896f;
constexpr float QSCALE = 0.125f * LOG2E;
constexpr size_t OFF_Y = 0;
constexpr size_t OFF_AK_P = 34603008, OFF_AV_P = 36700160, OFF_BK_P = 38797312, OFF_BV_P = 55574528, OFF_BL_P = 72351744;
constexpr size_t OFF_MK_P = 72613888, OFF_MV_P = 74711040, OFF_CV_P = 76808192;
constexpr size_t OFF_AK_S = 76853248, OFF_AV_S = 77377536, OFF_BK_S = 77901824, OFF_BV_S = 78426112, OFF_BL_S = 78950400, OFF_CV_S = 78958592;
constexpr size_t OUT_TOTAL = 79048704;
constexpr size_t MiB = 1u << 20;
constexpr size_t WS_WIN = 0, WS_WO = 10 * MiB, WS_WMQ = 12 * MiB, WS_WMO = 14 * MiB, WS_WUP = 16 * MiB, WS_WDN = 28 * MiB;
constexpr size_t WS_RSTD1 = 34 * MiB, WS_SS2 = 34 * MiB + 256 * 1024, WS_SS3 = 34 * MiB + 512 * 1024, WS_CTR = 34 * MiB + 768 * 1024;
constexpr size_t WS_GTAB = 34 * MiB + 800 * 1024;
constexpr size_t WS_CUMP = 35 * MiB, WS_CUMS = 36 * MiB;
constexpr size_t WS_MK = 40 * MiB, WS_MV = 52 * MiB, WS_MEMRAW = 64 * MiB;
constexpr size_t WS_XB = 80 * MiB, WS_P = 150 * MiB, WS_O = 348 * MiB;
constexpr size_t WS_X1B = 80 * MiB, WS_QM = 146 * MiB, WS_OM = 212 * MiB, WS_X2B = 278 * MiB;
constexpr size_t WS_AB = 80 * MiB, WS_SIDE = 348 * MiB;
constexpr size_t SIDE_ELEMS = (size_t)528 * 2 * DFF;
constexpr size_t WS_END = 414 * MiB;
constexpr int LDS_BYTES = 143360 + 256;
constexpr int LDS_NEXT = 143360;

struct Params { const float* in[32]; float* out; unsigned char* ws; };

DI int fresh_tid(int wave_s) {
    int w = wave_s; unsigned m = ~0u; asm volatile("" : "+s"(w), "+s"(m));
    int t = w * 64 + (int)__builtin_amdgcn_mbcnt_hi(m, __builtin_amdgcn_mbcnt_lo(m, 0u)); asm volatile("" : "+v"(t)); return t; }
DI unsigned pk2(float lo, float hi) { f32x2v v = {lo, hi}; bf16x2v b = __builtin_convertvector(v, bf16x2v); return __builtin_bit_cast(unsigned, b); }
DI float bf2f(unsigned short s) { return __uint_as_float(((unsigned)s) << 16); }
DI float red_max32(float x) { auto r = __builtin_amdgcn_permlane32_swap(__float_as_uint(x), __float_as_uint(x), false, false); return fmaxf(__uint_as_float(r[0]), __uint_as_float(r[1])); }
DI float red_sum32(float x) { auto r = __builtin_amdgcn_permlane32_swap(__float_as_uint(x), __float_as_uint(x), false, false); return __uint_as_float(r[0]) + __uint_as_float(r[1]); }
DI float red_max16(float x) { auto r = __builtin_amdgcn_permlane16_swap(__float_as_uint(x), __float_as_uint(x), false, false); return fmaxf(__uint_as_float(r[0]), __uint_as_float(r[1])); }
DI float red_sum16(float x) { auto r = __builtin_amdgcn_permlane16_swap(__float_as_uint(x), __float_as_uint(x), false, false); return __uint_as_float(r[0]) + __uint_as_float(r[1]); }
template <int CTRL> DI float dpp_mov(float x) { return __uint_as_float((unsigned)__builtin_amdgcn_update_dpp(0, (int)__float_as_uint(x), CTRL, 0xf, 0xf, false)); }
DI float row16_sum(float v) { v += dpp_mov<0x128>(v); v += dpp_mov<0x124>(v); v += dpp_mov<0x122>(v); v += dpp_mov<0x121>(v); return v; }
DI float wave_sum(float v) { return red_sum32(red_sum16(row16_sum(v))); }
DI float wave_max(float v) { v = fmaxf(v, dpp_mov<0x128>(v)); v = fmaxf(v, dpp_mov<0x124>(v)); v = fmaxf(v, dpp_mov<0x122>(v)); v = fmaxf(v, dpp_mov<0x121>(v)); return red_max32(red_max16(v)); }
DI float lane_read(float x, int src_lane) { return __uint_as_float((unsigned)__builtin_amdgcn_ds_bpermute(src_lane << 2, (int)__float_as_uint(x))); }
DI u32x4 pack8(const f32x4& a, const f32x4& b) { u32x4 w; w.x = pk2(a[0], a[1]); w.y = pk2(a[2], a[3]); w.z = pk2(b[0], b[1]); w.w = pk2(b[2], b[3]); return w; }

DI void transpose_item(const float* W, int ldw, int K, const float* gk, bf16_t* WT, int destrow0, int k0, int n0, LAS float* scr, int lane) {
    float tv[32];
#pragma unroll
    for (int i = 0; i < 32; ++i) { const int kk = 2 * i + (lane >> 5); tv[i] = __builtin_nontemporal_load(W + (size_t)(k0 + kk) * ldw + n0 + (lane & 31)); }
#pragma unroll
    for (int i = 0; i < 32; ++i) { const int kk = 2 * i + (lane >> 5); float v = tv[i]; if (gk) v *= gk[k0 + kk]; scr[kk * 33 + (lane & 31)] = v; }
    LDS_WAIT(); asm volatile("" ::: "memory");
    const int c = lane & 7;
#pragma unroll
    for (int j = 0; j < 4; ++j) { const int n = (lane >> 3) + 8 * j; const LAS float* s = scr + (8 * c) * 33 + n;
        u32x4 o; o.x = pk2(s[0 * 33], s[1 * 33]); o.y = pk2(s[2 * 33], s[3 * 33]); o.z = pk2(s[4 * 33], s[5 * 33]); o.w = pk2(s[6 * 33], s[7 * 33]);
        *(u32x4*)(WT + (size_t)(destrow0 + n) * K + k0 + 8 * c) = o; }
    LDS_WAIT(); asm volatile("" ::: "memory");
}

DI void p0_prologue(const Params& p, LAS unsigned char* lds, int tid) {
    const int lane = tid & 63, wave = tid >> 6, G = gridDim.x;
    const int gw = blockIdx.x * 8 + wave, NGW = G * 8;
    const int gt = blockIdx.x * 512 + tid, NGT = G * 512;
    unsigned char* ws = p.ws;
    { float* ss2 = (float*)(ws + WS_SS2); float* ss3 = (float*)(ws + WS_SS3);
      for (int i = gt; i < MT; i += NGT) { ss2[i] = 0.f; ss3[i] = 0.f; }
      if (gt < 128) ((unsigned*)(ws + WS_CTR))[gt] = 0u;
      if (gt < 384) { const int ty = gt >> 6, d = gt & 63; ((float*)(ws + WS_GTAB))[gt] = ty == 0 ? p.in[13][d] : ty == 1 ? p.in[14][d] : ty == 3 ? p.in[16][d] : ty == 4 ? p.in[17][d] : 1.f; } }
    LAS float* wfl = (LAS float*)(lds + 73728);
    { const float* w_in = p.in[11]; const float* g1 = p.in[19];
      for (int e = tid; e < 8192; e += 512) { const int c = e >> 10, k = e & 1023; wfl[e] = w_in[(size_t)k * 3080 + 3072 + c] * g1[k]; } }
    __syncthreads();
    LAS float* scr = (LAS float*)(lds + wave * 8448);
    {
        constexpr int I_IN = 16 * 96, I_MKV = 16 * 64, I_SQ = 16 * 32, I_UP = 16 * 176, I_DN = 44 * 32;
        constexpr int NITEMS = I_IN + I_MKV + 3 * I_SQ + I_UP + I_DN;
        bf16_t* WTin = (bf16_t*)(ws + WS_WIN);
        for (int it = gw; it < NITEMS; it += NGW) {
            int r = it;
            if (r < I_IN) { const int kb = r / 96, nb = r % 96, n0 = 32 * nb;
                const int T = n0 >> 8, wc = (n0 >> 6) & 3, bj = (n0 >> 5) & 1;
                transpose_item(p.in[11], 3080, 1024, p.in[19], WTin, 256 * T + 128 * bj + 32 * wc, 64 * kb, n0, scr, lane); continue; } r -= I_IN;
            if (r < I_MKV) { const int kb = r / 64, nb = r % 64; transpose_item(p.in[23], 2048, 1024, p.in[21], WTin, 3072 + 32 * nb, 64 * kb, 32 * nb, scr, lane); continue; } r -= I_MKV;
            if (r < I_SQ) { const int kb = r / 32, nb = r % 32; transpose_item(p.in[18], 1024, 1024, nullptr, (bf16_t*)(ws + WS_WO), 32 * nb, 64 * kb, 32 * nb, scr, lane); continue; } r -= I_SQ;
            if (r < I_SQ) { const int kb = r / 32, nb = r % 32; transpose_item(p.in[22], 1024, 1024, p.in[20], (bf16_t*)(ws + WS_WMQ), 32 * nb, 64 * kb, 32 * nb, scr, lane); continue; } r -= I_SQ;
            if (r < I_SQ) { const int kb = r / 32, nb = r % 32; transpose_item(p.in[26], 1024, 1024, nullptr, (bf16_t*)(ws + WS_WMO), 32 * nb, 64 * kb, 32 * nb, scr, lane); continue; } r -= I_SQ;
            if (r < I_UP) { const int kb = r / 176, nb = r % 176, n0 = 32 * nb;
                const int dest = (n0 < DFF) ? 256 * (n0 >> 7) + (n0 & 127) : 256 * ((n0 - DFF) >> 7) + 128 + ((n0 - DFF) & 127);
                transpose_item(p.in[28], 2 * DFF, 1024, p.in[27], (bf16_t*)(ws + WS_WUP), dest, 64 * kb, n0, scr, lane); continue; } r -= I_UP;
            { const int kb = r / 32, nb = r % 32; transpose_item(p.in[31], 1024, DFF, nullptr, (bf16_t*)(ws + WS_WDN), 32 * nb, 64 * kb, 32 * nb, scr, lane); }
        }
    }
    {
        bf16_t* XB = (bf16_t*)(ws + WS_XB); float* rstd1 = (float*)(ws + WS_RSTD1);
        const float* bfv = p.in[12];
        const int l16 = lane & 15, grp = lane >> 4;
        for (int row4 = gw * 4; row4 < MA; row4 += NGW * 4) {
            const int row = row4 + grp;
            const float* src = row < NP ? p.in[0] + (size_t)row * DM : (row < MT ? p.in[1] + (size_t)(row - NP) * DM : p.in[10] + (size_t)(row - MT) * DM);
            f32x4 v[16]; float ss = 0.f;
#pragma unroll
            for (int j = 0; j < 16; ++j) v[j] = __builtin_nontemporal_load((const f32x4*)src + l16 + 16 * j);
#pragma unroll
            for (int j = 0; j < 16; ++j) ss += (v[j][0] * v[j][0] + v[j][1] * v[j][1]) + (v[j][2] * v[j][2] + v[j][3] * v[j][3]);
            ss = row16_sum(ss);
            const float rstd = rsqrtf(ss * (1.f / DM) + EPS);
            unsigned long long* o8 = (unsigned long long*)(XB + (size_t)row * DM) + l16;
#pragma unroll
            for (int j = 0; j < 16; ++j) o8[16 * j] = (unsigned long long)pk2(v[j][0], v[j][1]) | ((unsigned long long)pk2(v[j][2], v[j][3]) << 32);
            if (l16 == 0) rstd1[row] = rstd;
            if (row4 < MT) {
                float a[8];
#pragma unroll
                for (int c = 0; c < 8; ++c) {
                    float acc_ = 0.f; const LAS f32x4* wp = (const LAS f32x4*)wfl + 256 * c + l16;
#pragma unroll
                    for (int j = 0; j < 16; ++j) { const f32x4 w = wp[16 * j]; acc_ += (v[j][0] * w[0] + v[j][1] * w[1]) + (v[j][2] * w[2] + v[j][3] * w[3]); }
                    acc_ = row16_sum(acc_);
                    a[c] = acc_;
                }
                if (l16 < 8) {
                    const float av = l16 == 0 ? a[0] : l16 == 1 ? a[1] : l16 == 2 ? a[2] : l16 == 3 ? a[3] : l16 == 4 ? a[4] : l16 == 5 ? a[5] : l16 == 6 ? a[6] : a[7];
                    const float z = av * rstd + bfv[l16];
                    const float lf = fminf(z, 0.f) - log1pf(expf(-fabsf(z)));
                    float* dst = row < NP ? p.out + OFF_BL_P + (size_t)row * 8 : p.out + OFF_BL_S + (size_t)(row - NP) * 8;
                    dst[l16] = lf;
                }
            }
        }
    }
    {
        const f32x4* ck = (const f32x4*)p.in[7]; const f32x4* cv = (const f32x4*)p.in[8]; const f32x4* gq = (const f32x4*)p.in[24];
        unsigned long long* mk = (unsigned long long*)(ws + WS_MK) + (size_t)8 * 256 * 1024 / 4;
        unsigned long long* mv = (unsigned long long*)(ws + WS_MV) + (size_t)8 * 256 * 1024 / 4;
        for (int i0 = gt; i0 < 16 * 256 * 1024 / 4; i0 += 4 * NGT) {
            f32x4 kk_[4], vv_[4];
#pragma unroll
            for (int j = 0; j < 4; ++j) { const int i = i0 + j * NGT; if (i < 16 * 256 * 1024 / 4) { kk_[j] = ck[i]; vv_[j] = cv[i]; } }
#pragma unroll
            for (int j = 0; j < 4; ++j) { const int i = i0 + j * NGT; if (i >= 16 * 256 * 1024 / 4) break; const f32x4 g = gq[i & 63]; const f32x4 k = kk_[j] * g, v = vv_[j];
                mk[i] = (unsigned long long)pk2(k[0], k[1]) | ((unsigned long long)pk2(k[2], k[3]) << 32);
                mv[i] = (unsigned long long)pk2(v[0], v[1]) | ((unsigned long long)pk2(v[2], v[3]) << 32); }
        }
    }
    __syncthreads();
}

struct DualOrder {
    int n1, G, c, nM2, n2, pm_off, pn_off, nM, nN;
    DI bool next(int i, Unit& u) const {
        long L = (long)i * G + c;
        if (L < n1) {
            int wgid = (int)L; { const int q = n1 / 8, xcd = wgid % 8, off = wgid / 8; wgid = xcd * q + off; }
            const int nig = 8 * nN, gid = wgid / nig, fm = gid * 8, gsz = (nM - fm) < 8 ? (nM - fm) : 8;
            u.pm = fm + ((wgid % nig) % gsz); u.pn = (wgid % nig) / gsz; return true;
        }
        L -= n1; if (L >= n2) return false;
        u.pm = pm_off + (int)(L % nM2); u.pn = pn_off + (int)(L / nM2); return true;
    }
    DI void a_ready(const Unit&) const {}
    DI void done(const Unit&) const {}
};

struct EpiInProj {
    static constexpr bool PERM = true, AFTER_DRAIN = false;
    const float* rstd1; bf16_t* P; float* out; float* memraw; const float* gtab;
    DI void operator()(const f32x4 (&acc)[2][2][4][2], const Unit& u, int wr, int wc, int fr, int fq) const {
        if (u.pn >= 12) {
#pragma unroll
            for (int ai = 0; ai < 2; ++ai)
#pragma unroll
                for (int m = 0; m < 4; ++m) { const int row = u.pm * 256 + ai * 128 + wr * 64 + m * 16 + fr; const float rs = rstd1[row];
                    float* dst = memraw + (size_t)(row - MT) * 2048 + (u.pn - 12) * 256 + wc * 32 + 8 * fq;
#pragma unroll
                    for (int bj = 0; bj < 2; ++bj) { *(f32x4*)(dst + bj * 128) = acc[ai][bj][m][0] * rs; *(f32x4*)(dst + bj * 128 + 4) = acc[ai][bj][m][1] * rs; } }
            return;
        }
        const int type = u.pn >> 1, head = 4 * (u.pn & 1) + wc;
        const bool isq = (type == 0 || type == 3), isk = (type == 1 || type == 4);
        const float* g = gtab + type * 64;
        f32x4 gv[2][2];
#pragma unroll
        for (int bj = 0; bj < 2; ++bj)
#pragma unroll
            for (int n = 0; n < 2; ++n) gv[bj][n] = *(const f32x4*)(g + 32 * bj + 8 * fq + 4 * n);
#pragma unroll
        for (int ai = 0; ai < 2; ++ai)
#pragma unroll
            for (int m = 0; m < 4; ++m) {
                const int row = u.pm * 256 + ai * 128 + wr * 64 + m * 16 + fr; const float rs = rstd1[row];
                f32x4 v[2][2];
#pragma unroll
                for (int bj = 0; bj < 2; ++bj)
#pragma unroll
                    for (int n = 0; n < 2; ++n) v[bj][n] = acc[ai][bj][m][n] * rs;
                if (isq || isk) {
                    float ss = 0.f;
#pragma unroll
                    for (int bj = 0; bj < 2; ++bj)
#pragma unroll
                        for (int n = 0; n < 2; ++n) ss += (v[bj][n][0] * v[bj][n][0] + v[bj][n][1] * v[bj][n][1]) + (v[bj][n][2] * v[bj][n][2] + v[bj][n][3] * v[bj][n][3]);
                    ss = red_sum32(red_sum16(ss));
                    float r = rsqrtf(ss * (1.f / 64.f) + EPS); if (isq) r *= QSCALE;
#pragma unroll
                    for (int bj = 0; bj < 2; ++bj)
#pragma unroll
                        for (int n = 0; n < 2; ++n) v[bj][n] = v[bj][n] * r * gv[bj][n];
                }
                bf16_t* prow = P + (size_t)row * NQKV + type * 512 + head * 64 + 8 * fq;
#pragma unroll
                for (int bj = 0; bj < 2; ++bj) *(u32x4*)(prow + 32 * bj) = pack8(v[bj][0], v[bj][1]);
                if (!isq) {
                    float* dst = nullptr;
                    if (row < NP) { const int b = row >> 12, t = row & 4095;
                        if (type <= 2) { if (t >= 3584) dst = out + (type == 1 ? OFF_AK_P : OFF_AV_P) + ((size_t)(b * 512 + t - 3584) * 8 + head) * 64; }
                        else dst = out + (type == 4 ? OFF_BK_P : OFF_BV_P) + ((size_t)row * 8 + head) * 64; }
                    else { const int rs_ = row - NP;
                        dst = out + (type == 1 ? OFF_AK_S : type == 2 ? OFF_AV_S : type == 4 ? OFF_BK_S : OFF_BV_S) + ((size_t)rs_ * 8 + head) * 64; }
                    if (dst) {
#pragma unroll
                        for (int bj = 0; bj < 2; ++bj) { __builtin_nontemporal_store(v[bj][0], (f32x4*)(dst + 32 * bj + 8 * fq)); __builtin_nontemporal_store(v[bj][1], (f32x4*)(dst + 32 * bj + 8 * fq + 4)); } }
                }
            }
    }
};

DI void bf8_to_f32(const u32x4& w, f32x4& a, f32x4& b) {
    a[0] = __uint_as_float(w.x << 16); a[1] = __uint_as_float(w.x & 0xffff0000u); a[2] = __uint_as_float(w.y << 16); a[3] = __uint_as_float(w.y & 0xffff0000u);
    b[0] = __uint_as_float(w.z << 16); b[1] = __uint_as_float(w.z & 0xffff0000u); b[2] = __uint_as_float(w.w << 16); b[3] = __uint_as_float(w.w & 0xffff0000u);
}
template <bool SRC16>
struct EpiRes {
    static constexpr bool PERM = true, AFTER_DRAIN = false;
    const float* src_p; const float* src_s; const bf16_t* src16; bf16_t* XB; float* ss;
    DI void operator()(const f32x4 (&acc)[2][2][4][2], const Unit& u, int wr, int wc, int fr, int fq) const {
#pragma unroll
        for (int ai = 0; ai < 2; ++ai)
#pragma unroll
            for (int m = 0; m < 4; ++m) {
                const int row = u.pm * 256 + ai * 128 + wr * 64 + m * 16 + fr;
                const float* src = row < NP ? src_p + (size_t)row * DM : src_s + (size_t)(row - NP) * DM;
                float sq = 0.f;
#pragma unroll
                for (int bj = 0; bj < 2; ++bj) { const int col = u.pn * 256 + bj * 128 + wc * 32 + 8 * fq;
                    f32x4 r0, r1;
                    if (SRC16) bf8_to_f32(*(const u32x4*)(src16 + (size_t)row * DM + col), r0, r1);
                    else { r0 = *(const f32x4*)(src + col); r1 = *(const f32x4*)(src + col + 4); }
                    const f32x4 v0 = r0 + acc[ai][bj][m][0], v1 = r1 + acc[ai][bj][m][1];
                    *(u32x4*)(XB + (size_t)row * DM + col) = pack8(v0, v1);
                    sq += (v0[0] * v0[0] + v0[1] * v0[1]) + (v0[2] * v0[2] + v0[3] * v0[3]) + (v1[0] * v1[0] + v1[1] * v1[1]) + (v1[2] * v1[2] + v1[3] * v1[3]); }
                sq = red_sum32(red_sum16(sq));
                if (fq == 0) atomicAdd(ss + row, sq);
            }
    }
};
struct EpiScaleBf16 {
    static constexpr bool PERM = true, AFTER_DRAIN = false;
    const float* ss; bf16_t* O;
    DI void operator()(const f32x4 (&acc)[2][2][4][2], const Unit& u, int wr, int wc, int fr, int fq) const {
#pragma unroll
        for (int ai = 0; ai < 2; ++ai)
#pragma unroll
            for (int m = 0; m < 4; ++m) {
                const int row = u.pm * 256 + ai * 128 + wr * 64 + m * 16 + fr; const float rs = rsqrtf(ss[row] * (1.f / DM) + EPS);
#pragma unroll
                for (int bj = 0; bj < 2; ++bj) { const int col = u.pn * 256 + bj * 128 + wc * 32 + 8 * fq;
                    *(u32x4*)(O + (size_t)row * DM + col) = pack8(acc[ai][bj][m][0] * rs, acc[ai][bj][m][1] * rs); }
            }
    }
};
DI f32x4 silu_mul(const f32x4& c, const f32x4& v) { f32x4 r;
#pragma unroll
    for (int e = 0; e < 4; ++e) r[e] = c[e] / (1.f + __expf(-c[e])) * v[e];
    return r; }
struct EpiUp {
    static constexpr bool PERM = true, AFTER_DRAIN = false;
    const float* ss3; const float* wconv; const float* bconv; bf16_t* Ab; float* gfirst; float* vfirst; float* glast;
    DI void operator()(const f32x4 (&acc)[2][2][4][2], const Unit& u, int wr, int wc, int fr, int fq) const {
        const int col0 = u.pn * 128 + wc * 32 + 8 * fq, lane = fr + 16 * fq;
        const int s1 = (lane & ~15) | ((lane - 1) & 15), s2 = (lane & ~15) | ((lane - 2) & 15);
        f32x4 w0[2], w1[2], w2[2], bc[2];
#pragma unroll
        for (int n = 0; n < 2; ++n) { w0[n] = *(const f32x4*)(wconv + col0 + 4 * n); w1[n] = *(const f32x4*)(wconv + DFF + col0 + 4 * n); w2[n] = *(const f32x4*)(wconv + 2 * DFF + col0 + 4 * n); bc[n] = *(const f32x4*)(bconv + col0 + 4 * n); }
#pragma unroll
        for (int ai = 0; ai < 2; ++ai) {
            const int blk = u.pm * 4 + ai * 2 + wr;
            f32x4 pR1[2], pR2[2];
#pragma unroll
            for (int n = 0; n < 2; ++n) { pR1[n] = (f32x4){0.f, 0.f, 0.f, 0.f}; pR2[n] = pR1[n]; }
#pragma unroll
            for (int m = 0; m < 4; ++m) {
                const int row = u.pm * 256 + ai * 128 + wr * 64 + m * 16 + fr; const float rs = rsqrtf(ss3[row] * (1.f / DM) + EPS);
                f32x4 a[2];
#pragma unroll
                for (int n = 0; n < 2; ++n) {
                    const f32x4 g = acc[ai][0][m][n] * rs, vv = acc[ai][1][m][n] * rs; f32x4 R1, R2;
#pragma unroll
                    for (int e = 0; e < 4; ++e) { R1[e] = dpp_mov<0x121>(g[e]); R2[e] = dpp_mov<0x122>(g[e]); }
                    const f32x4 p1 = fr >= 1 ? R1 : pR1[n], p2 = fr >= 2 ? R2 : pR2[n];
                    const f32x4 cv = p2 * w0[n] + p1 * w1[n] + g * w2[n] + bc[n];
                    a[n] = silu_mul(cv, vv);
                    pR1[n] = R1; pR2[n] = R2;
                    if (m == 0 && fr < 2) { *(f32x4*)(gfirst + ((size_t)blk * 2 + fr) * DFF + col0 + 4 * n) = g; *(f32x4*)(vfirst + ((size_t)blk * 2 + fr) * DFF + col0 + 4 * n) = vv; }
                    if (m == 3 && fr >= 14) *(f32x4*)(glast + ((size_t)blk * 2 + fr - 14) * DFF + col0 + 4 * n) = g;
                }
                if (!(m == 0 && fr < 2)) *(u32x4*)(Ab + (size_t)row * DFF + col0) = pack8(a[0], a[1]);
            }
        }
    }
};
struct EpiPartial {
    static constexpr bool PERM = true, AFTER_DRAIN = false;
    float* part;
    DI void operator()(const f32x4 (&acc)[2][2][4][2], const Unit& u, int wr, int wc, int fr, int fq) const {
#pragma unroll
        for (int ai = 0; ai < 2; ++ai)
#pragma unroll
            for (int m = 0; m < 4; ++m) {
                float* o = part + (size_t)(ai * 128 + wr * 64 + m * 16 + fr) * 256 + wc * 32 + 8 * fq;
#pragma unroll
                for (int bj = 0; bj < 2; ++bj) { *(f32x4*)(o + bj * 128) = acc[ai][bj][m][0]; *(f32x4*)(o + bj * 128 + 4) = acc[ai][bj][m][1]; }
            }
    }
};
struct OneUnit {
    int pm, pn;
    DI bool next(int i, Unit& u) const { if (i > 0) return false; u.pm = pm; u.pn = pn; return true; }
    DI void a_ready(const Unit&) const {}
    DI void done(const Unit&) const {}
};
struct EpiDown {
    static constexpr bool PERM = true, AFTER_DRAIN = false;
    const bf16_t* X2B; float* out;
    DI void operator()(const f32x4 (&acc)[2][2][4][2], const Unit& u, int wr, int wc, int fr, int fq) const {
#pragma unroll
        for (int ai = 0; ai < 2; ++ai)
#pragma unroll
            for (int m = 0; m < 4; ++m) {
                const int row = u.pm * 256 + ai * 128 + wr * 64 + m * 16 + fr;
#pragma unroll
                for (int bj = 0; bj < 2; ++bj) { const size_t off = (size_t)row * DM + u.pn * 256 + bj * 128 + wc * 32 + 8 * fq;
                    f32x4 r0, r1; bf8_to_f32(*(const u32x4*)(X2B + off), r0, r1);
                    __builtin_nontemporal_store(r0 + acc[ai][bj][m][0], (f32x4*)(out + off)); __builtin_nontemporal_store(r1 + acc[ai][bj][m][1], (f32x4*)(out + off + 4)); }
                if (m & 1) __builtin_amdgcn_sched_barrier(0);
            }
    }
};

DI void cumsum_bh(const Params& p, LAS unsigned char* lds, int tid, int idx) {
    LAS float* wsum = (LAS float*)lds;
    const int beta = idx >> 3, h = idx & 7, lane = tid & 63, w = tid >> 6;
    const bool sample = beta >= 8; const int b = sample ? beta - 8 : beta;
    const int per = sample ? 9 : 8, T = sample ? 4160 : 4096;
    const float* lf_new = sample ? p.out + OFF_BL_S + (size_t)b * 64 * 8 : p.out + OFF_BL_P + (size_t)b * 4096 * 8;
    const float* lf_cache = p.in[6] + (size_t)b * 4096 * 8;
    float* dst = sample ? (float*)(p.ws + WS_CUMS) + ((size_t)b * 8 + h) * 4160 : (float*)(p.ws + WS_CUMP) + ((size_t)b * 8 + h) * 4096;
    float v[9];
#pragma unroll
    for (int i = 0; i < 9; ++i) { const int t = tid * per + i; float x = 0.f;
        if (i < per && t < T) x = sample ? (t < 4096 ? lf_cache[(size_t)t * 8 + h] : lf_new[(size_t)(t - 4096) * 8 + h]) : lf_new[(size_t)t * 8 + h];
        v[i] = x; }
    float s = 0.f;
#pragma unroll
    for (int i = 0; i < 9; ++i) { s += v[i]; v[i] = s; }
    float incl = s;
#pragma unroll
    for (int off = 1; off < 64; off <<= 1) { const float y = lane_read(incl, (lane - off) & 63); if (lane >= off) incl += y; }
    if (lane == 63) wsum[w] = incl;
    __syncthreads();
    float base = 0.f;
#pragma unroll
    for (int j = 0; j < 8; ++j) if (j < w) base += wsum[j];
    const float excl = base + incl - s;
#pragma unroll
    for (int i = 0; i < 9; ++i) { const int t = tid * per + i; if (i < per && t < T) dst[t] = excl + v[i]; }
    __syncthreads();
}

struct AttnArgs {
    const bf16_t* Q; int qstride; int nq; int qpos0; int kt_lo, kt_hi;
    const float* k32; const float* v32; int stride32; int n32;
    const bf16_t* k16; const bf16_t* v16; int stride16;
    bf16_t* O; int ostride;
    const float* cum; const float* tab; const float* gq; const float* gk;
};
DI f32x16 mfma32(bf16x8 a, bf16x8 b, f32x16 c) { return __builtin_amdgcn_mfma_f32_32x32x16_bf16(a, b, c, 0, 0, 0); }
typedef short v4i16_t __attribute__((ext_vector_type(4)));
DI s16x4 vtr(const LAS unsigned char* p) { return __builtin_bit_cast(s16x4, __builtin_amdgcn_ds_read_tr16_b64_v4i16((LAS v4i16_t*)p)); }

template <int D, int MODE, bool F32, int DV, int EXP = 0>
DI void attn_unit(LAS unsigned char* lds, const AttnArgs& a, int tid, int vcol0) {
    constexpr int KSTR = D * 2 + 16, TILE = 64 * KSTR, NCH = D / 8, PER = (64 * NCH) / 512;
    constexpr int VSTR = DV == 64 ? 192 : 288, VTILE = 64 * VSTR, NCHV = DV / 8, PERV = (64 * NCHV) / 512, BUFB = TILE + VTILE;
    constexpr int CUM_OFF = 2 * BUFB, TAB_OFF = CUM_OFF + 512;
    const int lane = tid & 63, w = __builtin_amdgcn_readfirstlane(tid >> 6), r = lane & 31, h = lane >> 5;
    const bool wact = 32 * w < a.nq;
    const int qrow = 32 * w + r, qpos = a.qpos0 + qrow, qw0 = a.qpos0 + 32 * w;
    int w_lo, w_hi;
    if (MODE == 0) { const int c = qw0 >> 6; w_lo = c - 8 < 0 ? 0 : c - 8; w_hi = c; }
    else if (MODE == 1) { w_lo = 0; w_hi = qw0 >> 6; }
    else { w_lo = a.kt_lo; w_hi = a.kt_hi; }
    if (!wact) { w_lo = 1; w_hi = 0; }
    bf16x8 qf[D / 16];
    {
        const bf16_t* qp = a.Q + (size_t)(wact ? qrow : 0) * a.qstride + 8 * h;
#pragma unroll
        for (int kk = 0; kk < D / 16; ++kk) qf[kk] = *(const bf16x8*)(qp + 16 * kk);
    }
    float sc = 1.f;
    if (MODE == 2) {
        float ss = 0.f;
#pragma unroll
        for (int kk = 0; kk < D / 16; ++kk)
#pragma unroll
            for (int j = 0; j < 8; ++j) { const float f = bf2f((unsigned short)qf[kk][j]); ss += f * f; }
        ss = red_sum32(ss);
        sc = rsqrtf(ss * (1.f / 256.f) + EPS) * 0.0625f * LOG2E;
    }
    float cref = 0.f;
    if (MODE == 1) cref = a.cum[a.qpos0];
    float sinit = 0.f;
    if (MODE != 2) {
        float gm = wave_max(fabsf(a.gq[lane])) * wave_max(fabsf(a.gk[lane])) * 8.f * LOG2E;
        if (MODE == 0) { float tm = fabsf(a.tab[lane]); tm = fmaxf(tm, fabsf(a.tab[lane + 64])); tm = fmaxf(tm, fabsf(a.tab[lane + 128])); tm = fmaxf(tm, fabsf(a.tab[lane + 192])); tm = fmaxf(tm, fabsf(a.tab[256])); gm += wave_max(tm) * LOG2E; }
        sinit = -gm;
        if (MODE == 1) sinit += (a.cum[wact ? qpos : a.qpos0] - cref) * LOG2E;
    }
    LAS float* tabl = (LAS float*)(lds + TAB_OFF);
    if (MODE == 0) { if (tid < 257) { const int rel = 192 - tid; tabl[tid] = a.tab[(rel > 128 ? 128 : rel) + 128] * LOG2E; } }
    f32x16 o[DV / 32];
#pragma unroll
    for (int n = 0; n < DV / 32; ++n)
#pragma unroll
        for (int i = 0; i < 16; ++i) o[n][i] = 0.f;
    float mrun = -1e30f, lrun = 0.f;

    u32x4 kr[2][PER], vr[2][PERV]; f32x4 kr2[2], vr2[2], kr3[2], vr3[2]; bool was32[2] = {false, false}; float cumr[2] = {0.f, 0.f};
#pragma unroll
    for (int i_ = 0; i_ < 2; ++i_) { kr2[i_] = (f32x4){0.f, 0.f, 0.f, 0.f}; vr2[i_] = kr2[i_]; kr3[i_] = kr2[i_]; vr3[i_] = kr2[i_]; }
    constexpr int RPK = 512 / NCH, RPV = 512 / NCHV;
    const unsigned voffK = (unsigned)((tid / NCH) * a.stride16 + 8 * (tid % NCH)) * 2u, voffV = (unsigned)((tid / NCHV) * a.stride16 + 8 * (tid % NCHV)) * 2u;
    const unsigned voff32 = (unsigned)((tid >> 3) * a.stride32 + 8 * (tid & 7)) * 4u;
    const unsigned ldsK = (unsigned)((tid / NCH) * KSTR + 16 * (tid % NCH)), ldsV = (unsigned)(TILE + (tid / NCHV) * VSTR + 16 * (tid % NCHV));
#define ISSUE(S, KT) do { const int kt_ = (KT); \
        if (F32 && kt_ < a.n32) { was32[S] = true; \
            const char* kb32_ = (const char*)a.k32 + (size_t)(64 * kt_) * a.stride32 * 4; const char* vb32_ = (const char*)a.v32 + (size_t)(64 * kt_) * a.stride32 * 4; \
            kr3[S] = __builtin_nontemporal_load((const f32x4*)(kb32_ + voff32)); kr2[S] = __builtin_nontemporal_load((const f32x4*)(kb32_ + voff32 + 16)); vr3[S] = __builtin_nontemporal_load((const f32x4*)(vb32_ + voff32)); vr2[S] = __builtin_nontemporal_load((const f32x4*)(vb32_ + voff32 + 16)); }     \
        else { was32[S] = false; \
            const char* kb16_ = (const char*)a.k16 + (size_t)(64 * (kt_ - a.n32)) * a.stride16 * 2; const char* vb16_ = (const char*)(a.v16 + vcol0) + (size_t)(64 * (kt_ - a.n32)) * a.stride16 * 2; \
            _Pragma("unroll") for (int j_ = 0; j_ < PER; ++j_) kr[S][j_] = *(const u32x4*)(kb16_ + (size_t)(j_ * RPK) * a.stride16 * 2 + voffK); \
            _Pragma("unroll") for (int j_ = 0; j_ < PERV; ++j_) vr[S][j_] = *(const u32x4*)(vb16_ + (size_t)(j_ * RPV) * a.stride16 * 2 + voffV); } \
        if (MODE == 1 && tid < 64) cumr[S] = a.cum[64 * kt_ + tid]; } while (0)
#define WRITE(S, BUF) do { LAS unsigned char* kb_ = lds + (BUF) * BUFB; \
        if (F32 && was32[S]) { *(LAS u32x4*)(kb_ + ldsK) = pack8(kr3[S], kr2[S]); *(LAS u32x4*)(kb_ + ldsV) = pack8(vr3[S], vr2[S]); } \
        else { _Pragma("unroll") for (int j_ = 0; j_ < PER; ++j_) *(LAS u32x4*)(kb_ + ldsK + j_ * RPK * KSTR) = kr[S][j_]; \
            _Pragma("unroll") for (int j_ = 0; j_ < PERV; ++j_) *(LAS u32x4*)(kb_ + ldsV + j_ * RPV * VSTR) = vr[S][j_]; } \
        if (MODE == 1 && tid < 64) ((LAS float*)(lds + CUM_OFF))[(BUF) * 64 + tid] = (cumr[S] - cref) * LOG2E; } while (0)

    const int rs23 = (r & ~12) | ((r & 4) << 1) | ((r & 8) >> 1);
    const int i16 = lane & 15, q_ = i16 >> 2, p_ = i16 & 3, g_ = (lane >> 4) & 1;
    constexpr int DIR = (MODE == 1) ? -1 : 1;
    const int kt_first = DIR > 0 ? a.kt_lo : a.kt_hi, ntiles = a.kt_hi - a.kt_lo + 1;
    ISSUE(0, kt_first); if (ntiles > 1) ISSUE(1, kt_first + DIR);
    WRITE(0, 0); __syncthreads();
    for (int it0 = 0; it0 < ntiles; it0 += 2) {
#pragma unroll
      for (int half = 0; half < 2; ++half) {
        const int it = it0 + half; if (it >= ntiles) break;
        const int kt = kt_first + DIR * it;
        const int buf = half;
        if (it + 2 < ntiles) ISSUE(half, kt + 2 * DIR);
        if (EXP != 4 && kt >= w_lo && kt <= w_hi) {
            const LAS unsigned char* Kt = lds + buf * BUFB; const LAS unsigned char* Vt = Kt + TILE;
            const LAS float* cl = (const LAS float*)(lds + CUM_OFF) + buf * 64;
#pragma unroll
            for (int stp = 0; stp < 2; ++stp) {
                const int step = DIR > 0 ? stp : 1 - stp;
                const int kpos0 = 64 * kt + 32 * step;
                if (MODE == 1 && kpos0 > qw0) continue;
                f32x16 s;
                const bool farb = (MODE == 0) && (qw0 - (kpos0 + 31) >= 128);
                const float s0v = farb ? sinit + tabl[0] : sinit;
#pragma unroll
                for (int i = 0; i < 16; ++i) s[i] = (MODE == 2) ? 0.f : s0v;
                const LAS unsigned char* kp = Kt + (32 * step + rs23) * KSTR + 16 * h;
                const LAS unsigned char* vb = Vt + (32 * step + 8 * h + q_) * VSTR + 32 * g_ + 8 * p_;
                bf16x8 kf[D / 16]; s16x4 vlo[DV / 32][2], vhi[DV / 32][2];
#pragma unroll
                for (int kk = 0; kk < D / 16; ++kk) kf[kk] = *(const LAS bf16x8*)(kp + 32 * kk);
#pragma unroll
                for (int n = 0; n < DV / 32; ++n) { vlo[n][0] = vtr(vb + 64 * n); vhi[n][0] = vtr(vb + 4 * VSTR + 64 * n); vlo[n][1] = vtr(vb + 16 * VSTR + 64 * n); vhi[n][1] = vtr(vb + 20 * VSTR + 64 * n); }
                __builtin_amdgcn_sched_barrier(0);
#pragma unroll
                for (int kk = 0; kk < D / 16; ++kk) { if (EXP == 3) { s[kk] += bf2f((unsigned short)kf[kk][0]) + bf2f((unsigned short)kf[kk][3]); } else s = mfma32(kf[kk], qf[kk], s); }
                if (MODE == 0) {
                    if (!farb) {
                        { const LAS float* tb = tabl + (192 - qpos + kpos0 + 8 * h);
#pragma unroll
                        for (int i = 0; i < 16; ++i) s[i] += tb[16 * (i >> 3) + (i & 7)]; } }
                } else if (MODE == 1) {
                    const LAS f32x4* c4 = (const LAS f32x4*)(cl + 32 * step + 8 * h);
                    const f32x4 c0 = c4[0], c1 = c4[1], c2 = c4[4], c3 = c4[5];
#pragma unroll
                    for (int e = 0; e < 4; ++e) { s[e] -= c0[e]; s[4 + e] -= c1[e]; s[8 + e] -= c2[e]; s[12 + e] -= c3[e]; }
                    if (kpos0 == qw0) {
#pragma unroll
                        for (int i = 0; i < 16; ++i) if (16 * (i >> 3) + 8 * h + (i & 7) > r) s[i] = -1e30f; }
                } else {
#pragma unroll
                    for (int i = 0; i < 16; ++i) s[i] *= sc;
                }
                if (MODE == 2) {
                float mx = s[0];
#pragma unroll
                for (int i = 1; i < 16; ++i) mx = fmaxf(mx, s[i]);
                mx = red_max32(mx);
                if (__builtin_amdgcn_ballot_w64(mx > mrun) != 0ull) {
                    const float mnew = fmaxf(mrun, mx), alpha = __builtin_amdgcn_exp2f(mrun - mnew); mrun = mnew; lrun *= alpha;
#pragma unroll
                    for (int n = 0; n < DV / 32; ++n)
#pragma unroll
                        for (int i = 0; i < 16; ++i) o[n][i] *= alpha;
                }
                float psum = 0.f;
#pragma unroll
                for (int i = 0; i < 16; ++i) { s[i] = __builtin_amdgcn_exp2f(s[i] - mrun); psum += s[i]; }
                lrun += psum;
                } else {
                float psum = 0.f;
#pragma unroll
                for (int i = 0; i < 16; ++i) { s[i] = __builtin_amdgcn_exp2f(s[i]); psum += s[i]; }
                lrun += psum;
                }
                u32x4 pw0, pw1;
                pw0.x = pk2(s[0], s[1]); pw0.y = pk2(s[2], s[3]); pw0.z = pk2(s[4], s[5]); pw0.w = pk2(s[6], s[7]);
                pw1.x = pk2(s[8], s[9]); pw1.y = pk2(s[10], s[11]); pw1.z = pk2(s[12], s[13]); pw1.w = pk2(s[14], s[15]);
                const bf16x8 pf0 = __builtin_bit_cast(bf16x8, pw0), pf1 = __builtin_bit_cast(bf16x8, pw1);
#pragma unroll
                for (int n = 0; n < DV / 32; ++n) {
                    { const bf16x8 vf = __builtin_shufflevector(vlo[n][0], vhi[n][0], 0, 1, 2, 3, 4, 5, 6, 7); if (EXP == 3) o[n][0] += bf2f((unsigned short)vf[0]) * bf2f((unsigned short)pf0[n]); else o[n] = mfma32(vf, pf0, o[n]); }
                    { const bf16x8 vf = __builtin_shufflevector(vlo[n][1], vhi[n][1], 0, 1, 2, 3, 4, 5, 6, 7); if (EXP == 3) o[n][1] += bf2f((unsigned short)vf[1]) * bf2f((unsigned short)pf1[n]); else o[n] = mfma32(vf, pf1, o[n]); }
                }
            }
        }
        if (it + 1 < ntiles) WRITE(half ^ 1, buf ^ 1);
        __syncthreads();
      }
    }
#undef ISSUE
#undef WRITE
    if (wact) {
        const float lt = red_sum32(lrun), inv = 1.f / lt;
        bf16_t* op = a.O + vcol0 + (size_t)qrow * a.ostride + 4 * h;
#pragma unroll
        for (int n = 0; n < DV / 32; ++n)
#pragma unroll
            for (int i4 = 0; i4 < 4; ++i4) {
                const unsigned lo = pk2(o[n][4 * i4] * inv, o[n][4 * i4 + 1] * inv), hi = pk2(o[n][4 * i4 + 2] * inv, o[n][4 * i4 + 3] * inv);
                *(unsigned long long*)(op + 32 * n + 8 * i4) = (unsigned long long)lo | ((unsigned long long)hi << 32);
            }
    }
}

DI void memnorm_rows(const Params& p, int item, int tid) {
    const int lane = tid & 63, wave = tid >> 6;
    const float* raw = (const float*)(p.ws + WS_MEMRAW);
    bf16_t* MK = (bf16_t*)(p.ws + WS_MK); bf16_t* MV = (bf16_t*)(p.ws + WS_MV);
    const f32x4 gk = ((const f32x4*)p.in[25])[lane], gq = ((const f32x4*)p.in[24])[lane];
    for (int i = 0; i < 4; ++i) {
        const int row = item * 32 + wave * 4 + i; const float* rr = raw + (size_t)row * 2048;
#pragma unroll
        for (int hm = 0; hm < 4; ++hm) {
            f32x4 v = ((const f32x4*)(rr + hm * 256))[lane];
            float ss = (v[0] * v[0] + v[1] * v[1]) + (v[2] * v[2] + v[3] * v[3]); ss = wave_sum(ss);
            const float rs = rsqrtf(ss * (1.f / 256.f) + EPS);
            v = v * rs * gk;
            ((f32x4*)(p.out + OFF_MK_P + (size_t)row * 1024 + hm * 256))[lane] = v;
            const f32x4 vq = v * gq;
            ((unsigned long long*)(MK + (size_t)row * 1024 + hm * 256))[lane] = (unsigned long long)pk2(vq[0], vq[1]) | ((unsigned long long)pk2(vq[2], vq[3]) << 32);
            const f32x4 vv = ((const f32x4*)(rr + 1024 + hm * 256))[lane];
            ((f32x4*)(p.out + OFF_MV_P + (size_t)row * 1024 + hm * 256))[lane] = vv;
            ((unsigned long long*)(MV + (size_t)row * 1024 + hm * 256))[lane] = (unsigned long long)pk2(vv[0], vv[1]) | ((unsigned long long)pk2(vv[2], vv[3]) << 32);
        }
    }
}

DI void gbar(unsigned* ctr, unsigned target, int tid) {
    asm volatile("s_waitcnt vmcnt(0)" ::: "memory");
    __syncthreads();
    if (tid == 0) {
        __builtin_amdgcn_fence(__ATOMIC_RELEASE, "agent");
        asm volatile("s_waitcnt vmcnt(0)" ::: "memory");
        __hip_atomic_fetch_add(ctr, 1u, __ATOMIC_RELAXED, __HIP_MEMORY_SCOPE_AGENT);
        while (__hip_atomic_load(ctr, __ATOMIC_RELAXED, __HIP_MEMORY_SCOPE_AGENT) < target) __builtin_amdgcn_s_sleep(1);
        __builtin_amdgcn_fence(__ATOMIC_ACQUIRE, "agent");
        asm volatile("s_waitcnt vmcnt(0)" ::: "memory");
    }
    __syncthreads();
}

DI int next_unit(LAS unsigned char* lds, unsigned* ctr, int tid) {
    LAS unsigned* nw = (LAS unsigned*)(lds + LDS_NEXT);
    if (tid == 0) *nw = atomicAdd(ctr, 1u);
    __syncthreads();
    const int u = (int)*nw;
    __syncthreads();
    return u;
}

template <int EXP>
DI void p2_attention(const Params& p, LAS unsigned char* lds, int tid) {
    unsigned* ctr = (unsigned*)(p.ws + WS_CTR) + (EXP ? 8 : 0);
    const bf16_t* P = (const bf16_t*)(p.ws + WS_P); bf16_t* Ob = (bf16_t*)(p.ws + (EXP ? WS_XB : WS_O));
    for (;;) {
        const int u = next_unit(lds, ctr, tid);
        if (u >= 2368) break;
        AttnArgs a; a.qstride = NQKV; a.stride16 = NQKV; a.ostride = DM; a.stride32 = 512; a.n32 = 0; a.k32 = nullptr; a.v32 = nullptr; a.cum = nullptr; a.tab = nullptr; a.gq = nullptr; a.gk = nullptr;
        if (u < 128) { const int b = u >> 3, h = u & 7; const size_t r0 = (size_t)(NP + 64 * b);
            a.Q = P + r0 * NQKV + 1536 + 64 * h; a.nq = 64; a.qpos0 = 4096; a.kt_lo = 0; a.kt_hi = 64; a.n32 = 64;
            a.k32 = p.in[4] + (size_t)b * 4096 * 512 + 64 * h; a.v32 = p.in[5] + (size_t)b * 4096 * 512 + 64 * h;
            a.k16 = P + r0 * NQKV + 2048 + 64 * h; a.v16 = P + r0 * NQKV + 2560 + 64 * h; a.O = Ob + r0 * DM + 512 + 64 * h;
            a.cum = (const float*)(p.ws + WS_CUMS) + ((size_t)b * 8 + h) * 4160; a.gq = p.in[16]; a.gk = p.in[17];
            attn_unit<64, 1, true, 64, EXP>(lds, a, tid, 0);
        } else if (u < 1152) { const int v = u - 128, g = 15 - (v >> 6), b = (v & 63) >> 3, h = v & 7; const size_t r0 = (size_t)b * 4096;
            a.Q = P + (r0 + 256 * g) * NQKV + 1536 + 64 * h; a.nq = 256; a.qpos0 = 256 * g; a.kt_lo = 0; a.kt_hi = 4 * g + 3;
            a.k16 = P + r0 * NQKV + 2048 + 64 * h; a.v16 = P + r0 * NQKV + 2560 + 64 * h; a.O = Ob + (r0 + 256 * g) * DM + 512 + 64 * h;
            a.cum = (const float*)(p.ws + WS_CUMP) + ((size_t)b * 8 + h) * 4096; a.gq = p.in[16]; a.gk = p.in[17];
            attn_unit<64, 1, false, 64, EXP>(lds, a, tid, 0);
        } else if (u < 2176) { const int v = u - 1152, g = v >> 6, b = (v & 63) >> 3, h = v & 7; const size_t r0 = (size_t)b * 4096;
            a.Q = P + (r0 + 256 * g) * NQKV + 64 * h; a.nq = 256; a.qpos0 = 256 * g; a.kt_lo = 4 * g - 8 < 0 ? 0 : 4 * g - 8; a.kt_hi = 4 * g + 3;
            a.k16 = P + r0 * NQKV + 512 + 64 * h; a.v16 = P + r0 * NQKV + 1024 + 64 * h; a.O = Ob + (r0 + 256 * g) * DM + 64 * h;
            a.tab = p.in[15] + h * 257; a.gq = p.in[13]; a.gk = p.in[14];
            attn_unit<64, 0, false, 64, EXP>(lds, a, tid, 0);
        } else if (u < 2304) { const int v = u - 2176, b = v >> 3, h = v & 7; const size_t r0 = (size_t)(NP + 64 * b);
            a.Q = P + r0 * NQKV + 64 * h; a.nq = 64; a.qpos0 = 512; a.kt_lo = 0; a.kt_hi = 8; a.n32 = 8;
            a.k32 = p.in[2] + (size_t)b * 512 * 512 + 64 * h; a.v32 = p.in[3] + (size_t)b * 512 * 512 + 64 * h;
            a.k16 = P + r0 * NQKV + 512 + 64 * h; a.v16 = P + r0 * NQKV + 1024 + 64 * h; a.O = Ob + r0 * DM + 64 * h;
            a.tab = p.in[15] + h * 257; a.gq = p.in[13]; a.gk = p.in[14];
            attn_unit<64, 0, true, 64, EXP>(lds, a, tid, 0);
        } else {
            if (!EXP) memnorm_rows(p, u - 2304, tid);
        }
    }
}

DI f32x4 mfma16(bf16x8 a, bf16x8 b, f32x4 c) { return __builtin_amdgcn_mfma_f32_16x16x32_bf16(a, b, c, 0, 0, 0); }
DI void mem_attn_unit(LAS unsigned char* lds, const bf16_t* Q, const bf16_t* K, const bf16_t* V, bf16_t* O, int nq, int tid) {
    constexpr int KSTR = 560, TILE = 64 * KSTR, BUFB = 2 * TILE;
    const int lane = tid & 63, w = __builtin_amdgcn_readfirstlane(tid >> 6), col = lane & 15, quad = lane >> 4;
    const bool wact = 16 * w < nq;
    const int qrow = 16 * w + col;
    f32x4 o[16];
#pragma unroll
    for (int mb = 0; mb < 16; ++mb) o[mb] = (f32x4){0.f, 0.f, 0.f, 0.f};
    float mrun = -1e30f, lrun = 0.f;
    u32x4 kr[4], vr[4];
    const unsigned voff = (unsigned)((tid >> 5) * DM + 8 * (tid & 31)) * 2u, ldso = (unsigned)((tid >> 5) * KSTR + 16 * (tid & 31));
#define MISSUE(KT) do { const char* kb_ = (const char*)K + (size_t)(64 * (KT)) * DM * 2; const char* vb_ = (const char*)V + (size_t)(64 * (KT)) * DM * 2; \
        _Pragma("unroll") for (int j_ = 0; j_ < 4; ++j_) { kr[j_] = *(const u32x4*)(kb_ + (size_t)(16 * j_) * DM * 2 + voff); vr[j_] = *(const u32x4*)(vb_ + (size_t)(16 * j_) * DM * 2 + voff); } } while (0)
#define MWRITE(BUF) do { LAS unsigned char* b_ = lds + (BUF) * BUFB + ldso; \
        _Pragma("unroll") for (int j_ = 0; j_ < 4; ++j_) { *(LAS u32x4*)(b_ + 16 * j_ * KSTR) = kr[j_]; *(LAS u32x4*)(b_ + TILE + 16 * j_ * KSTR) = vr[j_]; } } while (0)
    const int q_ = col >> 2, p_ = col & 3;
    MISSUE(0);
    bf16x8 qf[8];
    { const bf16_t* qp = Q + (size_t)(wact ? qrow : 0) * DM + 8 * quad;
#pragma unroll
      for (int kk = 0; kk < 8; ++kk) qf[kk] = *(const bf16x8*)(qp + 32 * kk); }
    float ss = 0.f;
#pragma unroll
    for (int kk = 0; kk < 8; ++kk)
#pragma unroll
        for (int j = 0; j < 8; ++j) { const float f = bf2f((unsigned short)qf[kk][j]); ss += f * f; }
    ss = red_sum32(red_sum16(ss));
    const float sc = rsqrtf(ss * (1.f / 256.f) + EPS) * 0.0625f * LOG2E;
    MWRITE(0); __syncthreads();
#pragma unroll 1
    for (int kt = 0; kt < 4; ++kt) {
        const int buf = kt & 1; const bool more = kt < 3;
        if (more) MISSUE(kt + 1);
        if (wact) {
            const LAS unsigned char* Kt = lds + buf * BUFB; const LAS unsigned char* Vt = Kt + TILE;
#pragma unroll
            for (int step = 0; step < 2; ++step) {
                f32x4 s0 = {0.f, 0.f, 0.f, 0.f}, s1 = s0;
                const LAS unsigned char* kp = Kt + (32 * step + col) * KSTR + 16 * quad;
#pragma unroll
                for (int kk = 0; kk < 8; ++kk) { const bf16x8 k0 = *(const LAS bf16x8*)(kp + 64 * kk), k1 = *(const LAS bf16x8*)(kp + 16 * KSTR + 64 * kk);
                    s0 = mfma16(k0, qf[kk], s0); s1 = mfma16(k1, qf[kk], s1); }
                s0 = s0 * sc; s1 = s1 * sc;
                float mx = fmaxf(fmaxf(fmaxf(s0[0], s0[1]), fmaxf(s0[2], s0[3])), fmaxf(fmaxf(s1[0], s1[1]), fmaxf(s1[2], s1[3])));
                mx = red_max32(red_max16(mx));
                const float mnew = fmaxf(mrun, mx), alpha = __builtin_amdgcn_exp2f(mrun - mnew); mrun = mnew;
                float psum = 0.f;
#pragma unroll
                for (int i = 0; i < 4; ++i) { s0[i] = __builtin_amdgcn_exp2f(s0[i] - mnew); s1[i] = __builtin_amdgcn_exp2f(s1[i] - mnew); psum += s0[i] + s1[i]; }
                lrun = lrun * alpha + psum;
#pragma unroll
                for (int mb = 0; mb < 16; ++mb) o[mb] = o[mb] * alpha;
                u32x4 pw; pw.x = pk2(s0[0], s0[1]); pw.y = pk2(s0[2], s0[3]); pw.z = pk2(s1[0], s1[1]); pw.w = pk2(s1[2], s1[3]);
                const bf16x8 pf = __builtin_bit_cast(bf16x8, pw);
                const LAS unsigned char* vb = Vt + (32 * step + 4 * quad + q_) * KSTR + 8 * p_;
#pragma unroll
                for (int mb = 0; mb < 16; ++mb) { const s16x4 lo = vtr(vb + 32 * mb), hi = vtr(vb + 16 * KSTR + 32 * mb);
                    const bf16x8 vf = __builtin_shufflevector(lo, hi, 0, 1, 2, 3, 4, 5, 6, 7); o[mb] = mfma16(vf, pf, o[mb]); }
            }
        }
        if (more) MWRITE(buf ^ 1);
        __syncthreads();
    }
#undef MISSUE
#undef MWRITE
    if (wact) {
        const float lt = red_sum32(red_sum16(lrun));
        const float inv = 1.f / lt;
        bf16_t* op = O + (size_t)qrow * DM + 4 * quad;
#pragma unroll
        for (int mb = 0; mb < 16; ++mb)
            *(unsigned long long*)(op + 16 * mb) = (unsigned long long)pk2(o[mb][0] * inv, o[mb][1] * inv) | ((unsigned long long)pk2(o[mb][2] * inv, o[mb][3] * inv) << 32);
    }
}

DI void p5_mem_attention(const Params& p, LAS unsigned char* lds, int tid) {
    const bf16_t* QM = (const bf16_t*)(p.ws + WS_QM); bf16_t* OM = (bf16_t*)(p.ws + WS_OM);
    const bf16_t* MK = (const bf16_t*)(p.ws + WS_MK); const bf16_t* MV = (const bf16_t*)(p.ws + WS_MV);
    for (int u = (int)blockIdx.x; u < 1088; u += (int)gridDim.x) {
        size_t r0; int kvb, hm, nq;
        if (u < 1024) { const int g = u & 31, b = u >> 7; hm = (u >> 5) & 3; r0 = (size_t)b * 4096 + 128 * g; kvb = b; nq = 128; }
        else { const int v = u - 1024, b = v >> 2; hm = v & 3; r0 = (size_t)(NP + 64 * b); kvb = 8 + b; nq = 64; }
        mem_attn_unit(lds, QM + r0 * DM + 256 * hm, MK + (size_t)kvb * 256 * 1024 + 256 * hm, MV + (size_t)kvb * 256 * 1024 + 256 * hm, OM + r0 * DM + 256 * hm, nq, tid);
    }
}

DI void p8_fixup(const Params& p, int tid) {
    const int gt = blockIdx.x * 512 + tid, NGT = gridDim.x * 512;
    const float* gfirst = (const float*)(p.ws + WS_SIDE); const float* vfirst = gfirst + SIDE_ELEMS; const float* glast = vfirst + SIDE_ELEMS;
    bf16_t* Ab = (bf16_t*)(p.ws + WS_AB);
    const float* wconv = p.in[29]; const float* bconv = p.in[30]; const float* st = p.in[9];
    constexpr int C4 = DFF / 4;
    for (int idx = gt; idx < 528 * 2 * C4; idx += NGT) {
        const int c4 = idx % C4, bj = idx / C4, j = bj & 1, blk = bj >> 1, col = 4 * c4;
        const bool start = blk >= 512 || (blk & 63) == 0;
        f32x4 pa, pb;
        if (start) { if (blk >= 512) { const float* s = st + (size_t)(blk - 512) * 2 * DFF + col; pa = *(const f32x4*)s; pb = *(const f32x4*)(s + DFF); } else { pa = (f32x4){0.f, 0.f, 0.f, 0.f}; pb = pa; } }
        else { const float* s = glast + (size_t)(blk - 1) * 2 * DFF + col; pa = *(const f32x4*)s; pb = *(const f32x4*)(s + DFF); }
        const f32x4 g0 = *(const f32x4*)(gfirst + (size_t)blk * 2 * DFF + col), g1 = *(const f32x4*)(gfirst + ((size_t)blk * 2 + 1) * DFF + col);
        const f32x4 gm2 = j == 0 ? pa : pb, gm1 = j == 0 ? pb : g0, gc = j == 0 ? g0 : g1;
        const f32x4 vv = *(const f32x4*)(vfirst + ((size_t)blk * 2 + j) * DFF + col);
        const f32x4 cv = gm2 * *(const f32x4*)(wconv + col) + gm1 * *(const f32x4*)(wconv + DFF + col) + gc * *(const f32x4*)(wconv + 2 * DFF + col) + *(const f32x4*)(bconv + col);
        const f32x4 a = silu_mul(cv, vv);
        *(unsigned long long*)(Ab + (size_t)(blk * 64 + j) * DFF + col) = (unsigned long long)pk2(a[0], a[1]) | ((unsigned long long)pk2(a[2], a[3]) << 32);
    }
    for (int idx = gt; idx < 24 * 2 * C4; idx += NGT) {
        const int c4 = idx % C4, bj = idx / C4, j = bj & 1, b = bj >> 1, col = 4 * c4;
        const int blk = b < 8 ? 64 * b + 63 : 512 + (b - 8);
        const f32x4 g = *(const f32x4*)(glast + ((size_t)blk * 2 + j) * DFF + col);
        float* dst = b < 8 ? p.out + OFF_CV_P + ((size_t)b * 2 + j) * DFF + col : p.out + OFF_CV_S + ((size_t)(b - 8) * 2 + j) * DFF + col;
        *(f32x4*)dst = g;
    }
}


template <int NSPLIT, class Fin>
DI void splitk_tail(LAS unsigned char* lds, const bf16_t* A, const bf16_t* Bt, int Kpitch, int ntp, float* parts_base, unsigned* cnt_base, const Fin& fin, int wave_s) {
    if ((int)blockIdx.x >= 16 * NSPLIT) return;
    const int pc = (int)blockIdx.x, un = pc / NSPLIT, ks = pc % NSPLIT;
    float* parts = parts_base + (size_t)un * NSPLIT * 65536;
    pg8::Gemm g2{A + 64 * ntp * ks, Bt + 64 * ntp * ks, MT, 1024, Kpitch, ntp};
    OneUnit S2{128 + (un >> 2), un & 3};
    EpiPartial E2{parts + (size_t)ks * 65536};
    pg8::gemm_phase<EpiPartial, OneUnit, true, true>(lds, g2, S2, E2, fresh_tid(wave_s));
    gbar(cnt_base + un, (unsigned)NSPLIT, fresh_tid(wave_s));
    constexpr int RP = (256 + NSPLIT - 1) / NSPLIT, NJ = RP * 64 / 512;
    const int t = fresh_tid(wave_s), r0 = ks * RP;
#pragma unroll
    for (int j = 0; j < NJ; ++j) { const int e = t + 512 * j, rr = r0 + (e >> 6), c4 = (e & 63) * 4;
        if (rr < 256) { f32x4 acc_ = {0.f, 0.f, 0.f, 0.f};
#pragma unroll
            for (int q = 0; q < NSPLIT; ++q) acc_ += *(const f32x4*)(parts + (size_t)q * 65536 + rr * 256 + c4);
            fin((128 + (un >> 2)) * 256 + rr, (un & 3) * 256 + c4, acc_, t & 63); } }
}
DI f32x4 bf4_to_f32(unsigned long long w) { f32x4 a; const unsigned lo = (unsigned)w, hi = (unsigned)(w >> 32);
    a[0] = __uint_as_float(lo << 16); a[1] = __uint_as_float(lo & 0xffff0000u); a[2] = __uint_as_float(hi << 16); a[3] = __uint_as_float(hi & 0xffff0000u); return a; }
template <bool SRC16>
struct FinRes {
    const float* src; const bf16_t* src16; bf16_t* XB; float* ss;
    DI void operator()(int row, int col, const f32x4& a, int lane) const {
        f32x4 r;
        if (SRC16) r = bf4_to_f32(*(const unsigned long long*)(src16 + (size_t)row * DM + col)); else r = *(const f32x4*)(src + (size_t)(row - NP) * DM + col);
        const f32x4 v = r + a;
        *(unsigned long long*)(XB + (size_t)row * DM + col) = (unsigned long long)pk2(v[0], v[1]) | ((unsigned long long)pk2(v[2], v[3]) << 32);
        float sq = (v[0] * v[0] + v[1] * v[1]) + (v[2] * v[2] + v[3] * v[3]); sq = wave_sum(sq);
        if (lane == 0) atomicAdd(ss + row, sq);
    }
};
struct FinScale {
    const float* ss; bf16_t* O;
    DI void operator()(int row, int col, const f32x4& a, int) const {
        const float rs = rsqrtf(ss[row] * (1.f / DM) + EPS);
        *(unsigned long long*)(O + (size_t)row * DM + col) = (unsigned long long)pk2(a[0] * rs, a[1] * rs) | ((unsigned long long)pk2(a[2] * rs, a[3] * rs) << 32);
    }
};
struct FinDown {
    const bf16_t* X2B; float* out;
    DI void operator()(int row, int col, const f32x4& a, int) const { const size_t off = (size_t)row * DM + col;
        *(f32x4*)(out + off) = bf4_to_f32(*(const unsigned long long*)(X2B + off)) + a; }
};

__global__ void __launch_bounds__(512, 2) mega_fwd(Params p) {
    extern __shared__ __attribute__((aligned(16))) unsigned char lds_raw[];
    LAS unsigned char* lds = (LAS unsigned char*)lds_raw;
    const int wave_s = __builtin_amdgcn_readfirstlane((int)threadIdx.x >> 6), G = gridDim.x;
    unsigned char* ws = p.ws;
    unsigned* gctr = (unsigned*)(ws + WS_CTR) + 32; unsigned bar_k = 0;
#define TID() fresh_tid(wave_s)

#ifndef PM
#define PM 0x3ff
#endif
#ifndef PROBE_LO
#define PROBE_LO -1
#define PROBE_HI -1
#endif
#define STAMP(k) do { if (PROBE_LO >= 0 && blockIdx.x == 0 && TID() == 0) { unsigned long long* tsw = (unsigned long long*)(p.ws + WS_CTR + 1024); \
        if ((k) == PROBE_LO) tsw[0] = __builtin_amdgcn_s_memrealtime(); if ((k) == PROBE_HI + 1) tsw[1] = __builtin_amdgcn_s_memrealtime(); } } while (0)
    STAMP(0);
    if constexpr (PM & 1) p0_prologue(p, lds, TID());
    cg::this_grid().sync();
    STAMP(1);
    if constexpr ((PM >> 1) & 1) {
        pg8::Gemm g{(const bf16_t*)(ws + WS_XB), (const bf16_t*)(ws + WS_WIN), MA, 5120, 1024};
        DualOrder S; S.nM = 132; S.nN = 12; S.n1 = 132 * 12; S.G = G; S.c = (int)blockIdx.x; S.nM2 = 8; S.n2 = 64; S.pm_off = 132; S.pn_off = 12;
        EpiInProj E{(const float*)(ws + WS_RSTD1), (bf16_t*)(ws + WS_P), p.out, (float*)(ws + WS_MEMRAW), (const float*)(ws + WS_GTAB)};
        pg8::gemm_phase<EpiInProj, DualOrder, true, true>(lds, g, S, E, TID());
        if (blockIdx.x < 192) cumsum_bh(p, lds, TID(), (int)blockIdx.x);
    }
    gbar(gctr, (++bar_k) * (unsigned)G, TID());
    STAMP(2);
#ifdef P2EXP
    { if (blockIdx.x == 0 && TID() == 0) ((unsigned long long*)(p.ws + WS_CTR + 1024))[0] = __builtin_amdgcn_s_memrealtime();
      p2_attention<P2EXP>(p, lds, TID());
      gbar(gctr, (++bar_k) * (unsigned)G, TID());
      if (blockIdx.x == 0 && TID() == 0) ((unsigned long long*)(p.ws + WS_CTR + 1024))[1] = __builtin_amdgcn_s_memrealtime(); }
#endif
    if constexpr ((PM >> 2) & 1) p2_attention<0>(p, lds, TID());
    gbar(gctr, (++bar_k) * (unsigned)G, TID());
    STAMP(3);
    if constexpr ((PM >> 3) & 1) {
        pg8::Gemm g{(const bf16_t*)(ws + WS_O), (const bf16_t*)(ws + WS_WO), MT, 1024, 1024};
        pg8::StaticOrder S; S.init(MT, 1024, G, (int)blockIdx.x);
        EpiRes<true> E{nullptr, nullptr, (const bf16_t*)(ws + WS_XB), (bf16_t*)(ws + WS_X1B), (float*)(ws + WS_SS2)};
        pg8::gemm_phase<EpiRes<true>, pg8::StaticOrder, true, true>(lds, g, S, E, TID());
    }
    gbar(gctr, (++bar_k) * (unsigned)G, TID());
    STAMP(4);
    if constexpr ((PM >> 4) & 1) {
        pg8::Gemm g{(const bf16_t*)(ws + WS_X1B), (const bf16_t*)(ws + WS_WMQ), MT, 1024, 1024};
        pg8::StaticOrder S; S.init(MT, 1024, G, (int)blockIdx.x);
        EpiScaleBf16 E{(const float*)(ws + WS_SS2), (bf16_t*)(ws + WS_QM)};
        pg8::gemm_phase<EpiScaleBf16, pg8::StaticOrder, true, true>(lds, g, S, E, TID());
    }
    gbar(gctr, (++bar_k) * (unsigned)G, TID());
    STAMP(5);
    if constexpr ((PM >> 5) & 1) p5_mem_attention(p, lds, TID());
    gbar(gctr, (++bar_k) * (unsigned)G, TID());
    STAMP(6);
    if constexpr ((PM >> 6) & 1) {
        pg8::Gemm g{(const bf16_t*)(ws + WS_OM), (const bf16_t*)(ws + WS_WMO), MT, 1024, 1024};
        pg8::StaticOrder S; S.init(MT, 1024, G, (int)blockIdx.x);
        EpiRes<true> E{nullptr, nullptr, (const bf16_t*)(ws + WS_X1B), (bf16_t*)(ws + WS_X2B), (float*)(ws + WS_SS3)};
        pg8::gemm_phase<EpiRes<true>, pg8::StaticOrder, true, true>(lds, g, S, E, TID());
    }
    gbar(gctr, (++bar_k) * (unsigned)G, TID());
    STAMP(7);
    if constexpr ((PM >> 7) & 1) {
        pg8::Gemm g{(const bf16_t*)(ws + WS_X2B), (const bf16_t*)(ws + WS_WUP), MT, 2 * DFF, 1024};
        pg8::StaticOrder S; S.init(MT, 2 * DFF, G, (int)blockIdx.x);
        float* side = (float*)(ws + WS_SIDE);
        EpiUp E{(const float*)(ws + WS_SS3), p.in[29], p.in[30], (bf16_t*)(ws + WS_AB), side, side + SIDE_ELEMS, side + 2 * SIDE_ELEMS};
        pg8::gemm_phase<EpiUp, pg8::StaticOrder, true, true>(lds, g, S, E, TID());
    }
    gbar(gctr, (++bar_k) * (unsigned)G, TID());
    STAMP(8);
    if constexpr ((PM >> 8) & 1) p8_fixup(p, TID());
    gbar(gctr, (++bar_k) * (unsigned)G, TID());
    STAMP(9);
    if constexpr ((PM >> 9) & 1) {
        pg8::Gemm g{(const bf16_t*)(ws + WS_AB), (const bf16_t*)(ws + WS_WDN), NP, 1024, DFF};
        pg8::StaticOrder S; S.init(NP, 1024, G, (int)blockIdx.x);
        EpiDown E{(const bf16_t*)(ws + WS_X2B), p.out};
        pg8::gemm_phase<EpiDown, pg8::StaticOrder, true, true>(lds, g, S, E, TID());
        { FinDown F{(const bf16_t*)(ws + WS_X2B), p.out};
          splitk_tail<11>(lds, (const bf16_t*)(ws + WS_AB), (const bf16_t*)(ws + WS_WDN), DFF, 4, (float*)(ws + WS_SIDE), (unsigned*)(ws + WS_CTR) + 112, F, wave_s); }
    }
    if (PROBE_LO >= 0) { gbar(gctr, (++bar_k) * (unsigned)G, TID()); STAMP(10);
        if (blockIdx.x == 0 && TID() == 0) { volatile unsigned long long* tsw = (volatile unsigned long long*)(p.ws + WS_CTR + 1024); const unsigned long long te = __builtin_amdgcn_s_memrealtime(), d = 4ull * (tsw[1] - tsw[0]); while (__builtin_amdgcn_s_memrealtime() - te < d) __builtin_amdgcn_s_sleep(32); } }
}

extern "C" void kernel_launch(void* const* d_in, const int* in_sizes, int n_in, void* d_out, int out_size, void* d_ws, size_t ws_size, hipStream_t stream) {
    static int grid = 0;
    if (grid == 0) {
        if (n_in != 32 || (size_t)out_size != OUT_TOTAL || ws_size < WS_END) { fprintf(stderr, "kernel_launch: unexpected shapes: n_in %d out %d ws %zu\n", n_in, out_size, ws_size); grid = -1; return; }
        int dev = 0, cus = 0, per_cu = 0;
        hipGetDevice(&dev); hipDeviceGetAttribute(&cus, hipDeviceAttributeMultiprocessorCount, dev);
        if (hipFuncSetAttribute((const void*)mega_fwd, hipFuncAttributeMaxDynamicSharedMemorySize, LDS_BYTES) != hipSuccess) { fprintf(stderr, "kernel_launch: hipFuncSetAttribute failed\n"); grid = -1; return; }
        if (hipOccupancyMaxActiveBlocksPerMultiprocessor(&per_cu, (const void*)mega_fwd, 512, LDS_BYTES) != hipSuccess || per_cu < 1) { fprintf(stderr, "kernel_launch: occupancy query says %d\n", per_cu); per_cu = 1; }
        (void)hipGetLastError();
        grid = cus;
    }
    if (grid < 0) return;
    Params p{};
    for (int i = 0; i < 32; ++i) p.in[i] = (const float*)d_in[i];
    p.out = (float*)d_out; p.ws = (unsigned char*)d_ws;
    void* args[] = {&p};
    hipError_t e = hipLaunchCooperativeKernel((const void*)mega_fwd, dim3(grid), dim3(512), args, LDS_BYTES, stream);
    if (e != hipSuccess) fprintf(stderr, "cooperative launch failed: %s (grid %d)\n", hipGetErrorString(e), grid);
}
```
